# Optimizing an MI355X kernel written in HIP

```python
import jax, jax.numpy as jnp
from jax import lax
import numpy as np

D_MODEL = 1024
BATCH = 8
SEQ = 4096
DEPTH = 4

MIX_WIDTH = D_MODEL
CONV_WIDTH = MIX_WIDTH // 2
CONV_GROUPS = 8
CONV_K = 3
RET_HEADS = 4
RET_WIDTH = MIX_WIDTH - CONV_WIDTH
RET_HEAD_DIM = RET_WIDTH // RET_HEADS
CHUNK = 128
D_FF = 4 * D_MODEL
ROPE_BASE = 10000.0
EPS = 1e-6
N_MOD = 6
IN_SIZES = (CONV_WIDTH, CONV_WIDTH, CONV_WIDTH, RET_WIDTH, RET_WIDTH, RET_WIDTH, RET_WIDTH)
IN_COLS = sum(IN_SIZES)
IN_SPLITS = [int(s) for s in np.cumsum(IN_SIZES)[:-1]]

kernel_name = "hybrid_shortconv_retention_adaln_trunk"


def rms_norm(x, g):
    xf = x.astype(jnp.float32)
    y = xf * lax.rsqrt(jnp.mean(xf * xf, axis=-1, keepdims=True) + EPS)
    return (y * g.astype(jnp.float32)).astype(x.dtype)


def rope_tables(t, d):
    inv_freq = ROPE_BASE ** (-jnp.arange(0, d, 2, dtype=jnp.float32) / d)
    ang = jnp.arange(t, dtype=jnp.float32)[:, None] * inv_freq[None, :]
    return jnp.cos(ang), jnp.sin(ang)


def apply_rope(u, cos, sin):
    half = u.shape[-1] // 2
    u1, u2 = u[..., :half], u[..., half:]
    cs, sn = cos[None, :, None, :], sin[None, :, None, :]
    return jnp.concatenate([u1 * cs - u2 * sn, u1 * sn + u2 * cs], axis=-1)


def short_conv(u, w):
    return lax.conv_general_dilated(
        u, w[:, None, :].astype(u.dtype), window_strides=(1,),
        padding=[(CONV_K - 1, 0)], dimension_numbers=('NWC', 'WIO', 'NWC'),
        feature_group_count=u.shape[-1])


def retention_chunkwise(q, k, v):
    b, t, h, d = q.shape
    n = t // CHUNK
    log_g = jnp.log1p(-jnp.exp2(-5.0 - jnp.arange(h, dtype=jnp.float32)))
    idx = jnp.arange(CHUNK, dtype=jnp.float32)
    diff = idx[:, None] - idx[None, :]
    causal = diff >= 0
    inner_decay = jnp.where(causal[None],
                            jnp.exp(log_g[:, None, None] * jnp.where(causal, diff, 0.0)[None]),
                            0.0)
    xi = jnp.exp(log_g[:, None] * (idx + 1.0)[None])
    zeta = jnp.exp(log_g[:, None] * (CHUNK - 1.0 - idx)[None])
    chunk_decay = jnp.exp(log_g * CHUNK)

    qc = q.reshape(b, n, CHUNK, h, d)
    kc = k.reshape(b, n, CHUNK, h, d)
    vc = v.reshape(b, n, CHUNK, h, d)
    scores = jnp.einsum('bnihd,bnjhd->bnhij', qc, kc) * inner_decay[None, None]
    inner = jnp.einsum('bnhij,bnjhe->bnihe', scores, vc)
    kv = jnp.einsum('bnjhd,bnjhe,hj->nbhde', kc, vc, zeta)

    def step(state, kv_n):
        return state * chunk_decay[None, :, None, None] + kv_n, state

    _, states = lax.scan(step, jnp.zeros((b, h, d, d), jnp.float32), kv)
    cross = jnp.einsum('bnihd,nbhde,hi->bnihe', qc, states, xi)
    return (inner + cross).reshape(b, t, h, d)


def setup_inputs(seed: int = 0) -> dict:
    key = jax.random.key(seed)
    ks = jax.random.split(key, 14)
    f32 = jnp.float32
    x = jax.random.normal(ks[0], (BATCH, SEQ, D_MODEL), f32)
    c = jax.random.normal(ks[1], (BATCH, D_MODEL), f32)
    norm1_g = 1.0 + 0.05 * jax.random.normal(ks[2], (DEPTH, D_MODEL), f32)
    w_in = jax.random.normal(ks[3], (DEPTH, D_MODEL, IN_COLS), f32) * D_MODEL ** -0.5
    conv_w = jax.random.normal(ks[4], (DEPTH, CONV_K, CONV_WIDTH), f32) * CONV_K ** -0.5
    ret_norm_g = 1.0 + 0.05 * jax.random.normal(ks[5], (DEPTH, RET_WIDTH), f32)
    w_out = jax.random.normal(ks[6], (DEPTH, MIX_WIDTH, D_MODEL), f32) * MIX_WIDTH ** -0.5
    norm2_g = 1.0 + 0.05 * jax.random.normal(ks[7], (DEPTH, D_MODEL), f32)
    w_up = jax.random.normal(ks[8], (DEPTH, D_MODEL, D_FF), f32) * D_MODEL ** -0.5
    w_down = jax.random.normal(ks[9], (DEPTH, D_FF, D_MODEL), f32) * D_FF ** -0.5
    w_ada = jax.random.normal(ks[10], (DEPTH, D_MODEL, N_MOD * D_MODEL), f32) * (0.5 * D_MODEL ** -0.5)
    b_ada = 0.02 * jax.random.normal(ks[11], (DEPTH, N_MOD * D_MODEL), f32)
    final_g = 1.0 + 0.05 * jax.random.normal(ks[12], (D_MODEL,), f32)
    return {"x": x, "c": c, "norm1_g": norm1_g, "w_in": w_in, "conv_w": conv_w,
            "ret_norm_g": ret_norm_g, "w_out": w_out, "norm2_g": norm2_g,
            "w_up": w_up, "w_down": w_down, "w_ada": w_ada, "b_ada": b_ada,
            "final_g": final_g}


def reference(x, c, norm1_g, w_in, conv_w, ret_norm_g, w_out, norm2_g,
              w_up, w_down, w_ada, b_ada, final_g):
    b, t, _ = x.shape
    cos, sin = rope_tables(t, RET_HEAD_DIM)
    c_act = jax.nn.silu(c)
    for l in range(DEPTH):
        mod = (c_act @ w_ada[l] + b_ada[l])[:, None, :]
        sh1, sc1, g1, sh2, sc2, g2 = jnp.split(mod, N_MOD, axis=-1)

        h = rms_norm(x, norm1_g[l]) * (1.0 + sc1) + sh1
        proj = h @ w_in[l]
        cb, cc, cu, q, k, v, gr = jnp.split(proj, IN_SPLITS, axis=-1)

        y_conv = cb * short_conv(cc * cu, conv_w[l])

        qh = apply_rope(q.astype(jnp.float32).reshape(b, t, RET_HEADS, RET_HEAD_DIM), cos, sin)
        kh = apply_rope(k.astype(jnp.float32).reshape(b, t, RET_HEADS, RET_HEAD_DIM), cos, sin)
        kh = kh * (RET_HEAD_DIM ** -0.5)
        vh = v.astype(jnp.float32).reshape(b, t, RET_HEADS, RET_HEAD_DIM)
        o = retention_chunkwise(qh, kh, vh)
        mu = jnp.mean(o, axis=-1, keepdims=True)
        var = jnp.mean(jnp.square(o - mu), axis=-1, keepdims=True)
        o = ((o - mu) * lax.rsqrt(var + EPS)).reshape(b, t, RET_WIDTH)
        o = (o * ret_norm_g[l].astype(jnp.float32)).astype(x.dtype)
        y_ret = jax.nn.silu(gr) * o

        mix = jnp.concatenate([y_conv, y_ret], axis=-1) @ w_out[l]
        x = x + g1 * mix

        h2 = rms_norm(x, norm2_g[l]) * (1.0 + sc2) + sh2
        x = x + g2 * (jnp.square(jax.nn.relu(h2 @ w_up[l])) @ w_down[l])

    return rms_norm(x, final_g)
```

```cpp
#include <hip/hip_runtime.h>
#include <hip/hip_cooperative_groups.h>
#include <cstdio>
#include <cstdint>
namespace cg = cooperative_groups;
namespace pg8 {
#define PG8_LAS __attribute__((address_space(3)))
typedef unsigned short bf16_t;
typedef short bf16x8 __attribute__((ext_vector_type(8)));
typedef float f32x4 __attribute__((ext_vector_type(4)));
typedef unsigned u32x4 __attribute__((ext_vector_type(4)));
constexpr int BM = 256, BK = 64, HALF = 128, HTB = HALF * BK * 2  , STAGE_BYTES = 8 * HTB, NXCD = 8, WGM = 4;

__host__ __device__ __forceinline__ int lds_byte(int r, int c) { const int st = (r >> 4) * 2 + (c >> 5), rr = r & 15, cc = c & 31, ob = rr * 64 + cc * 2; return st * 1024 + (ob ^ (((ob >> 9) & 1) << 5)); }
__host__ __device__ __forceinline__ void stage_rc(int b, int& R, int& C) { const int st = b / 1024, sb = b % 1024, swz = sb ^ (((sb >> 9) & 1) << 5); R = (st >> 1) * 16 + swz / 64; C = (st & 1) * 32 + (swz % 64) / 2; }
__host__ __device__ __forceinline__ int perm32(int rho) { const int n = rho >> 4, i = rho & 15; return 8 * (i >> 2) + 4 * n + (i & 3); }

struct Unit { int pm, pn; };
struct Gemm { const bf16_t* A; const bf16_t* Bt; int M, N, K; };

struct StaticOrder {
    int nM, nN, nwg, G, c;
    __host__ __device__ void init(int M, int N, int G_, int c_) { nM = M / BM; nN = N / BM; nwg = nM * nN; G = G_; c = c_; }
    __host__ __device__ bool next(int i, Unit& u) const {
        const long L = (long)i * G + c; if (L >= nwg) return false;
        int wgid = (int)L; { const int q = nwg / NXCD, r = nwg % NXCD, xcd = wgid % NXCD, off = wgid / NXCD; wgid = (xcd < r ? xcd * (q + 1) : r * (q + 1) + (xcd - r) * q) + off; }
        const int nig = WGM * nN, gid = wgid / nig, fm = gid * WGM, gsz = (nM - fm) < WGM ? (nM - fm) : WGM;
        u.pm = fm + ((wgid % nig) % gsz); u.pn = (wgid % nig) / gsz; return true;
    }
    __device__ __forceinline__ void a_ready(const Unit&) const {}
    __device__ __forceinline__ void done(const Unit&) const {}
};

__device__ __forceinline__ unsigned cvt_pk_bf16(float lo, float hi) { unsigned r; asm volatile("v_cvt_pk_bf16_f32 %0, %1, %2" : "=v"(r) : "v"(lo), "v"(hi)); return r; }
typedef unsigned u32x2 __attribute__((ext_vector_type(2)));
struct EpiInProj {
    static constexpr bool PERM = true, AFTER_DRAIN = false;
    bf16_t* O; const float* cs; const float* sn; const float* dq; const float* dk;
    bf16_t* KT; int ldk;
    __device__ __forceinline__ void operator()(const f32x4 (&acc)[2][2][4][2], const Unit& u, int wr, int wc, int fr, int fq) const {
        const int row0 = u.pm * BM + wr * 64 + fr, col0 = u.pn * BM + wc * 32 + 8 * fq;
        const bool rope = (u.pn >= 6 && u.pn < 10);
        const float* dtab = (u.pn >= 8) ? dk : dq;
        const int hb = (u.pn & 1) * 2;
        if (rope) {
#pragma unroll
            for (int ai = 0; ai < 2; ++ai) {
                f32x4 c4[4], s4[4]; float sc[4][2];
#pragma unroll
                for (int m = 0; m < 4; ++m) { const int row = row0 + ai * HALF + m * 16, t = row & 4095, p = t & 127;
                    c4[m] = *(const f32x4*)(cs + t * 64 + 16 * wc + 4 * fq); s4[m] = *(const f32x4*)(sn + t * 64 + 16 * wc + 4 * fq);
                    sc[m][0] = dtab[hb * 128 + p]; sc[m][1] = dtab[(hb + 1) * 128 + p]; }
                __builtin_amdgcn_sched_barrier(0);
#pragma unroll
                for (int m = 0; m < 4; ++m) { bf16_t* rowp = O + (size_t)(row0 + ai * HALF + m * 16) * 3072 + col0;
#pragma unroll
                    for (int bj = 0; bj < 2; ++bj) {
                        const float s_ = sc[m][bj]; const f32x4 cc = c4[m], ss = s4[m];
                        const f32x4 v0 = acc[ai][bj][m][0], v1 = acc[ai][bj][m][1];
                        u32x4 w;
                        w.x = cvt_pk_bf16((v0[0] * cc[0] - v0[1] * ss[0]) * s_, (v0[0] * ss[0] + v0[1] * cc[0]) * s_);
                        w.y = cvt_pk_bf16((v0[2] * cc[1] - v0[3] * ss[1]) * s_, (v0[2] * ss[1] + v0[3] * cc[1]) * s_);
                        w.z = cvt_pk_bf16((v1[0] * cc[2] - v1[1] * ss[2]) * s_, (v1[0] * ss[2] + v1[1] * cc[2]) * s_);
                        w.w = cvt_pk_bf16((v1[2] * cc[3] - v1[3] * ss[3]) * s_, (v1[2] * ss[3] + v1[3] * cc[3]) * s_);
                        *(u32x4*)(rowp + bj * HALF) = w;
                        if (u.pn >= 8) {
                            const int tokrow = row0 + ai * HALF + m * 16, odd = fr & 1;
                            bf16_t* kt = KT + (size_t)((hb + bj) * 128 + wc * 32 + 8 * fq + odd) * ldk + (tokrow - odd);
#pragma unroll
                            for (int q = 0; q < 4; ++q) { const unsigned mine = w[q], other = (unsigned)__shfl_xor((int)mine, 1);
                                const unsigned pr = odd ? ((other >> 16) | (mine & 0xffff0000u)) : ((mine & 0xffffu) | (other << 16));
                                *(unsigned*)(kt + (size_t)(2 * q) * ldk) = pr; }
                        }
                    } }
                __builtin_amdgcn_sched_barrier(0);
            }
        } else if (u.pn >= 12) {
            const int odd = fr & 1;
#pragma unroll
            for (int ai = 0; ai < 2; ++ai)
#pragma unroll
                for (int m = 0; m < 4; ++m) { const int tokrow = row0 + ai * HALF + m * 16;
#pragma unroll
                    for (int bj = 0; bj < 2; ++bj) {
                        const f32x4 v0 = acc[ai][bj][m][0], v1 = acc[ai][bj][m][1];
                        u32x4 w; w.x = cvt_pk_bf16(v0[0], v0[1]); w.y = cvt_pk_bf16(v0[2], v0[3]); w.z = cvt_pk_bf16(v1[0], v1[1]); w.w = cvt_pk_bf16(v1[2], v1[3]);
                        bf16_t* vt = KT + (size_t)(512 + (u.pn - 12) * BM + bj * HALF + wc * 32 + 8 * fq + odd) * ldk + (tokrow - odd);
#pragma unroll
                        for (int q = 0; q < 4; ++q) { const unsigned mine = w[q], other = (unsigned)__shfl_xor((int)mine, 1);
                            const unsigned pr = odd ? ((other >> 16) | (mine & 0xffff0000u)) : ((mine & 0xffffu) | (other << 16));
                            *(unsigned*)(vt + (size_t)(2 * q) * ldk) = pr; }
                    } }
        } else if (u.pn >= 2 && u.pn < 6) {
            const int c0 = (u.pn - 2) * 128 + wc * 16 + 4 * fq;
#pragma unroll
            for (int ai = 0; ai < 2; ++ai)
#pragma unroll
                for (int m = 0; m < 4; ++m) { bf16_t* rowp = O + (size_t)(row0 + ai * HALF + m * 16) * 3072 + 512 + c0;
#pragma unroll
                    for (int bj = 0; bj < 2; ++bj) {
                        const f32x4 v0 = acc[ai][bj][m][0], v1 = acc[ai][bj][m][1];
                        u32x2 w; w.x = cvt_pk_bf16(v0[0] * v0[1], v0[2] * v0[3]); w.y = cvt_pk_bf16(v1[0] * v1[1], v1[2] * v1[3]);
                        *(u32x2*)(rowp + 64 * bj) = w;
                    } }
        } else {
#pragma unroll
            for (int ai = 0; ai < 2; ++ai)
#pragma unroll
                for (int m = 0; m < 4; ++m) { bf16_t* rowp = O + (size_t)(row0 + ai * HALF + m * 16) * 3072 + col0;
#pragma unroll
                    for (int bj = 0; bj < 2; ++bj) {
                        const f32x4 v0 = acc[ai][bj][m][0], v1 = acc[ai][bj][m][1];
                        u32x4 w; w.x = cvt_pk_bf16(v0[0], v0[1]); w.y = cvt_pk_bf16(v0[2], v0[3]); w.z = cvt_pk_bf16(v1[0], v1[1]); w.w = cvt_pk_bf16(v1[2], v1[3]);
                        *(u32x4*)(rowp + bj * HALF) = w;
                    } }
        }
    }
};
struct EpiKVT {
    static constexpr bool PERM = true, AFTER_DRAIN = false;
    bf16_t* O; const float* csT; const float* snT; const float* dk; int ldo;
    __device__ __forceinline__ void operator()(const f32x4 (&acc)[2][2][4][2], const Unit& u, int wr, int wc, int fr, int fq) const {
        const int col0 = u.pn * BM + wc * 32 + 8 * fq;
        if (u.pm < 2) {
#pragma unroll
            for (int bj = 0; bj < 2; ++bj) {
                const int tok = col0 + bj * HALF, t = tok & 4095;
                f32x4 c4[2][2], s4[2][2], d4[2][2];
#pragma unroll
                for (int mm = 0; mm < 2; ++mm)
#pragma unroll
                    for (int n = 0; n < 2; ++n) { const int i = 32 * wr + 16 * mm + fr;
                        c4[mm][n] = *(const f32x4*)(csT + i * (4096 + 32) + t + 4 * n); s4[mm][n] = *(const f32x4*)(snT + i * (4096 + 32) + t + 4 * n);
                        d4[mm][n] = *(const f32x4*)(dk + (2 * u.pm + mm) * 128 + (t & 127) + 4 * n); }
                __builtin_amdgcn_sched_barrier(0);
#pragma unroll
                for (int ai = 0; ai < 2; ++ai)
#pragma unroll
                    for (int mm = 0; mm < 2; ++mm) {
                        const int i = 32 * wr + 16 * mm + fr;
                        bf16_t* r1 = O + (size_t)((2 * u.pm + ai) * 128 + 2 * i) * ldo; bf16_t* r2 = r1 + ldo;
                        u32x4 w1, w2;
#pragma unroll
                        for (int n = 0; n < 2; ++n) {
                            const f32x4 cc = c4[mm][n], ss = s4[mm][n], dd = d4[ai][n];
                            const f32x4 x1 = acc[ai][bj][mm][n], x2 = acc[ai][bj][mm + 2][n];
                            const f32x4 o1 = (x1 * cc - x2 * ss) * dd, o2 = (x1 * ss + x2 * cc) * dd;
                            if (n == 0) { w1.x = cvt_pk_bf16(o1[0], o1[1]); w1.y = cvt_pk_bf16(o1[2], o1[3]); w2.x = cvt_pk_bf16(o2[0], o2[1]); w2.y = cvt_pk_bf16(o2[2], o2[3]); }
                            else        { w1.z = cvt_pk_bf16(o1[0], o1[1]); w1.w = cvt_pk_bf16(o1[2], o1[3]); w2.z = cvt_pk_bf16(o2[0], o2[1]); w2.w = cvt_pk_bf16(o2[2], o2[3]); }
                        }
                        *(u32x4*)(r1 + tok) = w1; *(u32x4*)(r2 + tok) = w2;
                    }
                __builtin_amdgcn_sched_barrier(0);
            }
        } else {
#pragma unroll
            for (int ai = 0; ai < 2; ++ai)
#pragma unroll
                for (int m = 0; m < 4; ++m) {
                    bf16_t* rowp = O + (size_t)(u.pm * BM + ai * HALF + wr * 64 + m * 16 + fr) * ldo + col0;
#pragma unroll
                    for (int bj = 0; bj < 2; ++bj) {
                        const f32x4 v0 = acc[ai][bj][m][0], v1 = acc[ai][bj][m][1];
                        u32x4 w; w.x = cvt_pk_bf16(v0[0], v0[1]); w.y = cvt_pk_bf16(v0[2], v0[3]); w.z = cvt_pk_bf16(v1[0], v1[1]); w.w = cvt_pk_bf16(v1[2], v1[3]);
                        *(u32x4*)(rowp + bj * HALF) = w;
                    }
                }
        }
    }
};
struct EpiVT {
    static constexpr bool PERM = true, AFTER_DRAIN = false;
    bf16_t* O; int ldo;
    __device__ __forceinline__ void operator()(const f32x4 (&acc)[2][2][4][2], const Unit& u, int wr, int wc, int fr, int fq) const {
        const int col0 = u.pn * BM + wc * 32 + 8 * fq;
#pragma unroll
        for (int ai = 0; ai < 2; ++ai)
#pragma unroll
            for (int m = 0; m < 4; ++m) {
                bf16_t* rowp = O + (size_t)(u.pm * BM + ai * HALF + wr * 64 + m * 16 + fr) * ldo + col0;
#pragma unroll
                for (int bj = 0; bj < 2; ++bj) {
                    const f32x4 v0 = acc[ai][bj][m][0], v1 = acc[ai][bj][m][1];
                    u32x4 w; w.x = cvt_pk_bf16(v0[0], v0[1]); w.y = cvt_pk_bf16(v0[2], v0[3]); w.z = cvt_pk_bf16(v1[0], v1[1]); w.w = cvt_pk_bf16(v1[2], v1[3]);
                    *(u32x4*)(rowp + bj * HALF) = w;
                }
            }
    }
};
struct EpiRes {
    static constexpr bool PERM = false, AFTER_DRAIN = false;
    const float* base; float* out; const float* gate;
    __device__ __forceinline__ void operator()(const f32x4 (&acc)[2][2][4][2], const Unit& u, int wr, int wc, int fr, int fq) const {
        const int b = u.pm >> 4, col0 = u.pn * BM + wc * 32 + 4 * fq, row0 = u.pm * BM + wr * 64 + fr;
        f32x4 g[2][2];
#pragma unroll
        for (int bj = 0; bj < 2; ++bj)
#pragma unroll
            for (int n = 0; n < 2; ++n) g[bj][n] = *(const f32x4*)(gate + b * 6144 + col0 + bj * HALF + n * 16);
#pragma unroll
        for (int ai = 0; ai < 2; ++ai) {
            f32x4 bs[4][2][2];
#pragma unroll
            for (int m = 0; m < 4; ++m) { const size_t off = (size_t)(row0 + ai * HALF + m * 16) * 1024 + col0;
#pragma unroll
                for (int bj = 0; bj < 2; ++bj)
#pragma unroll
                    for (int n = 0; n < 2; ++n) bs[m][bj][n] = *(const f32x4*)(base + off + bj * HALF + n * 16); }
            __builtin_amdgcn_sched_barrier(0);
#pragma unroll
            for (int m = 0; m < 4; ++m) { const size_t off = (size_t)(row0 + ai * HALF + m * 16) * 1024 + col0;
#pragma unroll
                for (int bj = 0; bj < 2; ++bj)
#pragma unroll
                    for (int n = 0; n < 2; ++n) *(f32x4*)(out + off + bj * HALF + n * 16) = bs[m][bj][n] + g[bj][n] * acc[ai][bj][m][n]; }
            __builtin_amdgcn_sched_barrier(0);
        }
    }
};
struct EpiRelu2 {
    static constexpr bool PERM = true, AFTER_DRAIN = false;
    bf16_t* O; int ldc;
    __device__ __forceinline__ void operator()(const f32x4 (&acc)[2][2][4][2], const Unit& u, int wr, int wc, int fr, int fq) const {
        const int row0 = u.pm * BM + wr * 64 + fr, col0 = u.pn * BM + wc * 32 + 8 * fq;
#pragma unroll
        for (int ai = 0; ai < 2; ++ai)
#pragma unroll
            for (int m = 0; m < 4; ++m) {
                bf16_t* rowp = O + (size_t)(row0 + ai * HALF + m * 16) * ldc + col0;
#pragma unroll
                for (int bj = 0; bj < 2; ++bj) {
                    f32x4 v0 = acc[ai][bj][m][0], v1 = acc[ai][bj][m][1];
                    v0 = __builtin_elementwise_max(v0, (f32x4){0.f, 0.f, 0.f, 0.f}); v1 = __builtin_elementwise_max(v1, (f32x4){0.f, 0.f, 0.f, 0.f});
                    v0 = v0 * v0; v1 = v1 * v1;
                    u32x4 w; w.x = cvt_pk_bf16(v0[0], v0[1]); w.y = cvt_pk_bf16(v0[2], v0[3]); w.z = cvt_pk_bf16(v1[0], v1[1]); w.w = cvt_pk_bf16(v1[2], v1[3]);
                    __builtin_nontemporal_store(w, (u32x4*)(rowp + bj * HALF));
                }
            }
    }
};
template <class Epi, class Sched, bool ALIGN_EPI = false, bool SP2 = false>
__device__ __forceinline__ void gemm_phase(PG8_LAS unsigned char* lds, const Gemm g, const Sched& S, const Epi& E) {
    int tid = threadIdx.x; asm volatile("" : "+v"(tid));
    const int wid = __builtin_amdgcn_readfirstlane(tid >> 6), lane = tid & 63, wr = wid >> 2, wc = wid & 3, fr = lane & 15, fq = lane >> 4;
    const int K = g.K, nt = K / BK;
    unsigned voffA[2], voffB[2];
#pragma unroll
    for (int i = 0; i < 2; ++i) { int R, C; stage_rc(tid * 16 + i * 8192, R, C); const int Rb = Epi::PERM ? ((R & ~31) + perm32(R & 31)) : R;
        voffA[i] = (unsigned)(R * K + C) * 2u; voffB[i] = (unsigned)(Rb * K + C) * 2u; }
    const size_t kstep = (size_t)(BK * 2);
    const size_t hstep = (size_t)HALF * K * 2;
    const size_t tstep = 2 * hstep;
    const unsigned ldsw = (unsigned)wid * 1024u;
    const int aoff = lds_byte(wr * 64 + fr, fq * 8), boff = lds_byte(wc * 32 + fr, fq * 8);
#define PG8_SA(b, h) (((b) * 2 + (h)) * HTB)
#define PG8_SB(b, h) ((4 + (b) * 2 + (h)) * HTB)
#define PG8_STAGE(bufoff, gbase, voff) do { _Pragma("unroll") for (int _i = 0; _i < 2; ++_i) \
        __builtin_amdgcn_global_load_lds((const unsigned*)((const char*)(gbase) + (voff)[_i]), (PG8_LAS unsigned*)(lds + (bufoff) + ldsw + _i * 8192), 16, 0, 0); } while (0)
#define PG8_LDA(dst, b, h) do { _Pragma("unroll") for (int m = 0; m < 4; ++m) _Pragma("unroll") for (int k = 0; k < 2; ++k) dst[m][k] = *(const PG8_LAS bf16x8*)(lds + PG8_SA(b, h) + aoff + m * 2048 + k * 1024); } while (0)
#define PG8_LDB(dst, b, h) do { _Pragma("unroll") for (int n = 0; n < 2; ++n) _Pragma("unroll") for (int k = 0; k < 2; ++k) dst[n][k] = *(const PG8_LAS bf16x8*)(lds + PG8_SB(b, h) + boff + n * 2048 + k * 1024); } while (0)
#define PG8_MMA(ai, bj, At, Bt) do { __builtin_amdgcn_s_setprio(1); _Pragma("unroll") for (int m = 0; m < 4; ++m) _Pragma("unroll") for (int n = 0; n < 2; ++n) _Pragma("unroll") for (int k = 0; k < 2; ++k) \
        acc[ai][bj][m][n] = __builtin_amdgcn_mfma_f32_16x16x32_bf16(Bt[n][k], At[m][k], acc[ai][bj][m][n], 0, 0, 0); __builtin_amdgcn_s_setprio(0); } while (0)
#define PG8_WAIT_V(n) asm volatile("s_waitcnt vmcnt(" #n ")" ::: "memory")
#define PG8_WAIT_L(n) asm volatile("s_waitcnt lgkmcnt(" #n ")" ::: "memory")
#define PG8_BAR __builtin_amdgcn_s_barrier()
#define PG8_SCHED __builtin_amdgcn_sched_barrier(0)
    Unit cur, nxt; int ui = 0;
    if (!S.next(0, cur)) return;
    f32x4 acc[2][2][4][2];
#pragma unroll
    for (int a = 0; a < 2; ++a)
#pragma unroll
        for (int b = 0; b < 2; ++b)
#pragma unroll
            for (int m = 0; m < 4; ++m)
#pragma unroll
                for (int n = 0; n < 2; ++n) acc[a][b][m][n] = (f32x4){0.f, 0.f, 0.f, 0.f};
    bf16x8 At[4][2], B0[2][2], B1[2][2];
    const char* cA = (const char*)g.A + (size_t)cur.pm * tstep; const char* cB = (const char*)g.Bt + (size_t)cur.pn * tstep;
    S.a_ready(cur);
    if constexpr (SP2) {
        PG8_STAGE(PG8_SB(0, 0), cB, voffB); PG8_STAGE(PG8_SB(0, 1), cB + hstep, voffB); PG8_STAGE(PG8_SA(0, 0), cA, voffA); PG8_STAGE(PG8_SA(0, 1), cA + hstep, voffA);
        if (wr == 1) PG8_BAR;
        PG8_WAIT_V(2); PG8_BAR;
        PG8_STAGE(PG8_SB(1, 0), cB + kstep, voffB); PG8_STAGE(PG8_SA(1, 0), cA + kstep, voffA); PG8_STAGE(PG8_SB(1, 1), cB + hstep + kstep, voffB);
        PG8_WAIT_V(6); PG8_BAR;
    } else {
        PG8_STAGE(PG8_SB(0, 0), cB, voffB); PG8_STAGE(PG8_SA(0, 0), cA, voffA); PG8_STAGE(PG8_SB(0, 1), cB + hstep, voffB); PG8_STAGE(PG8_SA(0, 1), cA + hstep, voffA);
        if (wr == 1) PG8_BAR;
        PG8_WAIT_V(4); PG8_BAR;
        PG8_STAGE(PG8_SB(1, 0), cB + kstep, voffB); PG8_STAGE(PG8_SA(1, 0), cA + kstep, voffA); PG8_STAGE(PG8_SB(1, 1), cB + hstep + kstep, voffB);
        PG8_WAIT_V(6); PG8_BAR;
    }
    for (;;) {
        const bool has_next = S.next(ui + 1, nxt);
        const char* nA = has_next ? (const char*)g.A + (size_t)nxt.pm * tstep : cA; const char* nB = has_next ? (const char*)g.Bt + (size_t)nxt.pn * tstep : cB;
        for (int t = 0; t < nt; t += 2) {
            const bool last = (t == nt - 2);
            const char* a1 = cA + (size_t)(t + 1) * kstep;
            const char* a2 = last ? nA : cA + (size_t)(t + 2) * kstep; const char* b2 = last ? nB : cB + (size_t)(t + 2) * kstep;
            const char* a3 = a2 + kstep; const char* b3 = b2 + kstep;
            if (last && has_next) S.a_ready(nxt);
            if constexpr (SP2) {
            PG8_LDB(B0, 0, 0); PG8_LDB(B1, 0, 1); PG8_SCHED; PG8_LDA(At, 0, 0); PG8_STAGE(PG8_SA(1, 1), a1 + hstep, voffA);
            PG8_WAIT_V(8); PG8_WAIT_L(0); PG8_BAR; PG8_MMA(0, 0, At, B0); PG8_MMA(0, 1, At, B1); PG8_BAR; PG8_SCHED;
            PG8_LDA(At, 0, 1); PG8_STAGE(PG8_SB(0, 0), b2, voffB); PG8_STAGE(PG8_SB(0, 1), b2 + hstep, voffB); PG8_STAGE(PG8_SA(0, 0), a2, voffA);
            PG8_WAIT_V(8); PG8_WAIT_L(0); PG8_BAR; PG8_MMA(1, 0, At, B0); PG8_MMA(1, 1, At, B1); PG8_BAR; PG8_SCHED;
            PG8_LDB(B0, 1, 0); PG8_LDB(B1, 1, 1); PG8_SCHED; PG8_LDA(At, 1, 0); PG8_STAGE(PG8_SA(0, 1), a2 + hstep, voffA);
            PG8_WAIT_V(8); PG8_WAIT_L(0); PG8_BAR; PG8_MMA(0, 0, At, B0); PG8_MMA(0, 1, At, B1); PG8_BAR; PG8_SCHED;
            PG8_LDA(At, 1, 1); PG8_STAGE(PG8_SB(1, 0), b3, voffB); PG8_STAGE(PG8_SB(1, 1), b3 + hstep, voffB); PG8_STAGE(PG8_SA(1, 0), a3, voffA);
            PG8_WAIT_V(8); PG8_WAIT_L(0); PG8_BAR; PG8_MMA(1, 0, At, B0); PG8_MMA(1, 1, At, B1); PG8_BAR; PG8_SCHED;
            } else {
            PG8_LDB(B0, 0, 0); PG8_SCHED; PG8_LDA(At, 0, 0); PG8_STAGE(PG8_SA(1, 1), a1 + hstep, voffA);
            PG8_WAIT_L(8); PG8_BAR; PG8_WAIT_L(0); PG8_MMA(0, 0, At, B0); PG8_BAR; PG8_SCHED;
            PG8_LDB(B1, 0, 1); PG8_STAGE(PG8_SB(0, 0), b2, voffB);
            PG8_BAR; PG8_WAIT_L(0); PG8_MMA(0, 1, At, B1); PG8_BAR;
            PG8_LDA(At, 0, 1); PG8_STAGE(PG8_SA(0, 0), a2, voffA);
            PG8_BAR; PG8_WAIT_L(0); PG8_MMA(1, 0, At, B0); PG8_BAR; PG8_SCHED;
            PG8_STAGE(PG8_SB(0, 1), b2 + hstep, voffB);
            PG8_WAIT_V(6); PG8_BAR; PG8_MMA(1, 1, At, B1); PG8_BAR;
            PG8_LDB(B0, 1, 0); PG8_SCHED; PG8_LDA(At, 1, 0); PG8_STAGE(PG8_SA(0, 1), a2 + hstep, voffA);
            PG8_WAIT_L(8); PG8_BAR; PG8_WAIT_L(0); PG8_MMA(0, 0, At, B0); PG8_BAR; PG8_SCHED;
            PG8_LDB(B1, 1, 1); PG8_STAGE(PG8_SB(1, 0), b3, voffB);
            PG8_BAR; PG8_WAIT_L(0); PG8_MMA(0, 1, At, B1); PG8_BAR;
            PG8_LDA(At, 1, 1); PG8_STAGE(PG8_SA(1, 0), a3, voffA);
            PG8_BAR; PG8_WAIT_L(0); PG8_MMA(1, 0, At, B0); PG8_BAR; PG8_SCHED;
            PG8_STAGE(PG8_SB(1, 1), b3 + hstep, voffB);
            PG8_WAIT_V(6); PG8_BAR; PG8_MMA(1, 1, At, B1); PG8_BAR;
            }
        }
        if constexpr (ALIGN_EPI) { if (wr == 0) PG8_BAR; }
        if constexpr (!Epi::AFTER_DRAIN) { E(acc, cur, wr, wc, fr, fq); S.done(cur); }
        if (!has_next) break;
#pragma unroll
        for (int a = 0; a < 2; ++a)
#pragma unroll
            for (int b = 0; b < 2; ++b)
#pragma unroll
                for (int m = 0; m < 4; ++m)
#pragma unroll
                    for (int n = 0; n < 2; ++n) acc[a][b][m][n] = (f32x4){0.f, 0.f, 0.f, 0.f};
        cur = nxt; cA = nA; cB = nB; ++ui;
        if constexpr (ALIGN_EPI) { if (wr == 1) PG8_BAR; }
    }
    PG8_WAIT_V(0);
    if constexpr (!ALIGN_EPI) { if (wr == 0) PG8_BAR; }
    PG8_BAR;
    if constexpr (Epi::AFTER_DRAIN) { E.fused(acc, cur, wr, wc, fr, fq, lds, wid, lane); S.done(cur); }
#undef PG8_SA
#undef PG8_SB
#undef PG8_STAGE
#undef PG8_LDA
#undef PG8_LDB
#undef PG8_MMA
#undef PG8_WAIT_V
#undef PG8_WAIT_L
#undef PG8_BAR
#undef PG8_SCHED
}
}
#define LAS __attribute__((address_space(3)))
typedef unsigned short bf16;
typedef unsigned v4u __attribute__((ext_vector_type(4)));
typedef unsigned v2u __attribute__((ext_vector_type(2)));
typedef float f32x4 __attribute__((ext_vector_type(4)));
typedef short bf16x8 __attribute__((ext_vector_type(8)));

constexpr int NWAVES = 8, NTHR = NWAVES * 64;
constexpr int BATCH = 8, T = 4096, D = 1024, DEPTH = 4, M = BATCH * T;
constexpr int NHEAD = 4, HD = 128, NCH = T / 128, FF = 4096, NIN = 3584, NMOD = 6 * D;
constexpr int N1 = 3072, N2 = 1024;
constexpr float EPS = 1e-6f;
constexpr size_t MiB = 1u << 20;
constexpr size_t WS_MOD = 0, CTL_ZERO_BYTES = 1 * MiB;
constexpr size_t WS_BAR = 800 * 1024;
constexpr int KVT_LD = M + 64, CST_LD = T + 32;
constexpr size_t WS_COS = 1 * MiB, WS_SIN = 2 * MiB, WS_COST = 3 * MiB, WS_SINT = 4 * MiB + 256 * 1024, WS_DQ = 5 * MiB + 512 * 1024, WS_DK = WS_DQ + 4096;
constexpr size_t WS_W = 6 * MiB;
constexpr size_t W_LAYER = 26 * MiB, W_T1 = 0, W_T2 = 6 * MiB, W_O = 8 * MiB, W_U = 10 * MiB, W_D = 18 * MiB;
constexpr size_t WS_XN = WS_W + DEPTH * W_LAYER;
constexpr size_t WS_P1 = WS_XN + 64 * MiB;
constexpr size_t WS_KVT = WS_P1 + 192 * MiB;
constexpr size_t WS_H = WS_P1;
constexpr size_t WS_ST = WS_KVT + 65 * MiB;
constexpr size_t WS_END = WS_ST + 32 * MiB;
constexpr size_t WS_CH = WS_DQ + 65536, CH_X0 = WS_CH, CH_H0 = WS_CH + 32768, CH_P0 = WS_CH + 65536, CH_Y0 = CH_P0 + 8 * 3584 * 4, CH_U0 = CH_Y0 + 32768;
static_assert(CH_U0 + 8 * 4096 * 4 <= 6 * MiB, "chain buffers");
constexpr int LDS_BYTES = 147456;
#ifndef REP_PRO
#define REP_PRO 1
#endif
#ifndef REP_PRO_T
#define REP_PRO_T 1
#endif
#ifndef REP_NORM
#define REP_NORM 1
#endif
#ifndef REP_GEMM_IN
#define REP_GEMM_IN 1
#endif
#ifndef REP_GEMM_UP
#define REP_GEMM_UP 1
#endif
#ifndef REP_RET1
#define REP_RET1 1
#endif
#ifndef REP_RET2
#define REP_RET2 1
#endif
#ifndef XSYNC
#define XSYNC 0
#endif
#ifndef MK_CG_ONLY
#define MK_CG_ONLY 0
#endif
#ifndef MK_NANFILL
#define MK_NANFILL 0
#endif
#ifndef MK_PER_PHASE
#define MK_PER_PHASE 0
#endif

__device__ __forceinline__ unsigned f2bf(float f) { unsigned u = __builtin_bit_cast(unsigned, f); return (u + 0x7fffu + ((u >> 16) & 1u)) >> 16; }
__device__ __forceinline__ unsigned pk2(float lo, float hi) { return f2bf(lo) | (f2bf(hi) << 16); }
__device__ __forceinline__ float bf2f(unsigned short h) { return __builtin_bit_cast(float, (unsigned)h << 16); }
__device__ __forceinline__ float bflo(unsigned w) { return __builtin_bit_cast(float, w << 16); }
__device__ __forceinline__ float bfhi(unsigned w) { return __builtin_bit_cast(float, w & 0xffff0000u); }
#define LDS_WAIT() asm volatile("s_waitcnt lgkmcnt(0)" ::: "memory")
__device__ __forceinline__ float wave_sum(float v) {
#pragma unroll
    for (int o = 1; o < 64; o <<= 1) v += __shfl_xor(v, o);
    return v;
}

__device__ __forceinline__ void tr_load(const float* W, int N, int k0, int n0, LAS float* scr, int lane) {
    float tv[32];
#pragma unroll
    for (int i = 0; i < 32; ++i) tv[i] = W[(size_t)(k0 + 2 * i + (lane >> 5)) * N + n0 + (lane & 31)];
#pragma unroll
    for (int i = 0; i < 32; ++i) scr[(2 * i + (lane >> 5)) * 33 + (lane & 31)] = tv[i];
    LDS_WAIT(); asm volatile("" ::: "memory");
}
__device__ __forceinline__ void win_rows(int c, int& r1, int& r2) {
    const int seg = c >> 9, j = c & 511, head = j >> 7, d = j & 127, i = d & 63, half = d >> 6;
    const int permQ = 2 * i + half, permT = 64 * (i >> 5) + 32 * half + (i & 31);
    r1 = -1; r2 = -1;
    if (seg == 0) r1 = c;
    else if (seg < 3) r1 = 512 + 2 * j + (seg - 1);
    else if (seg == 3) r1 = 1536 + head * 128 + permQ;
    else if (seg == 4) { r1 = 2048 + head * 128 + permQ; (void)permT; }
    else if (seg == 5) r2 = j;
    else r1 = 2560 + j;
}
__device__ __forceinline__ void tr_store_plain(bf16* WT, int K, int k0, int n0, const LAS float* scr, int lane) {
    const int c = lane & 7;
#pragma unroll
    for (int j = 0; j < 4; ++j) { const int n = (lane >> 3) + 8 * j; const LAS float* s = scr + (8 * c) * 33 + n;
        v4u o; o.x = pk2(s[0 * 33], s[1 * 33]); o.y = pk2(s[2 * 33], s[3 * 33]); o.z = pk2(s[4 * 33], s[5 * 33]); o.w = pk2(s[6 * 33], s[7 * 33]);
        *(v4u*)(WT + (size_t)(n0 + n) * K + k0 + 8 * c) = o; }
}
__device__ __forceinline__ void tr_store_win(bf16* Wt1, bf16* Wt2, int k0, int n0, const LAS float* scr, int lane) {
    const int c = lane & 7;
#pragma unroll
    for (int j = 0; j < 4; ++j) { const int n = (lane >> 3) + 8 * j; const LAS float* s = scr + (8 * c) * 33 + n;
        v4u o; o.x = pk2(s[0 * 33], s[1 * 33]); o.y = pk2(s[2 * 33], s[3 * 33]); o.z = pk2(s[4 * 33], s[5 * 33]); o.w = pk2(s[6 * 33], s[7 * 33]);
        int r1, r2; win_rows(n0 + n, r1, r2);
        if (r1 >= 0) *(v4u*)(Wt1 + (size_t)r1 * D + k0 + 8 * c) = o;
        if (r2 >= 0) *(v4u*)(Wt2 + (size_t)r2 * D + k0 + 8 * c) = o; }
}

struct Args { const float* in[13]; float* out; unsigned char* ws; int ph_lo, ph_hi; };

__device__ __forceinline__ void prologue(const Args& a, LAS unsigned char* lds, int tid, int lane, int wave, int bid, int G) {
    unsigned char* ws = a.ws;
    const int gw = bid * NWAVES + wave, NGW = G * NWAVES, gt = bid * NTHR + tid, NGT = G * NTHR;
    {
        float* cs = (float*)(ws + WS_COS); float* sn = (float*)(ws + WS_SIN);
        LAS float* invf = (LAS float*)(lds + 131072 + 256);
        if (tid < 64) invf[tid] = (float)pow(10000.0, -(double)(2 * tid) / 128.0);
        __syncthreads();
        for (int e = gt; e < T * 64; e += NGT) {
            const int t = e >> 6, i = e & 63;
            const double ang = (double)((float)t * invf[i]);
            const double q = __builtin_rint(ang * 0.15915494309189535);
            const float r = (float)(ang - q * 6.283185307179586);
            const float c = cosf(r), s = sinf(r);
            cs[e] = c; sn[e] = s;
        }
        if (bid == 0) {
            float* dq = (float*)(ws + WS_DQ); float* dk = (float*)(ws + WS_DK);
            const int h = tid >> 7, p = tid & 127;
            const double lg = log1p(-exp2(-5.0 - (double)h));
            dq[tid] = (float)exp(lg * (double)(p + 1));
            dk[tid] = (float)(exp(-lg * (double)(p + 1)) * 0.08838834764831845);
            if (p == 0) dk[512 + h] = (float)exp(128.0 * lg);
        }
    }
    {
        LAS float* cact = (LAS float*)(lds + 98304);
        const float* c = a.in[1];
        for (int e = tid; e < BATCH * D; e += NTHR) { const float v = c[e]; cact[e] = v / (1.f + __expf(-v)); }
        __syncthreads();
        float* mod = (float*)(ws + WS_MOD); const float* w_ada = a.in[10]; const float* b_ada = a.in[11];
        LAS float* red = (LAS float*)(lds + 131072 + 256);
        const int col = lane & 31, kh = lane >> 5, k0 = wave * 128;
        for (int it = bid; it < DEPTH * (NMOD / 32); it += G) {
            const int cb = it % (NMOD / 32), l = it / (NMOD / 32);
            const float* W = w_ada + (size_t)l * D * NMOD + (size_t)(k0 + kh) * NMOD + cb * 32 + col;
            float acc[8];
#pragma unroll
            for (int b = 0; b < 8; ++b) acc[b] = 0.f;
            for (int j0 = 0; j0 < 64; j0 += 32) {
                float wv[32];
#pragma unroll
                for (int j = 0; j < 32; ++j) wv[j] = W[(size_t)(2 * (j0 + j)) * NMOD];
#pragma unroll
                for (int j = 0; j < 32; ++j)
#pragma unroll
                    for (int b = 0; b < 8; ++b) acc[b] += cact[b * D + k0 + 2 * (j0 + j) + kh] * wv[j];
            }
#pragma unroll
            for (int b = 0; b < 8; ++b) acc[b] += __shfl_xor(acc[b], 32);
            if (kh == 0) {
#pragma unroll
                for (int b = 0; b < 8; ++b) red[(wave * 8 + b) * 32 + col] = acc[b]; }
            __syncthreads();
            if (tid < 256) { const int b = tid >> 5, c = tid & 31; float s_ = 0.f;
#pragma unroll
                for (int w = 0; w < 8; ++w) s_ += red[(w * 8 + b) * 32 + c];
                mod[((size_t)l * 8 + b) * NMOD + cb * 32 + c] = s_ + b_ada[l * NMOD + cb * 32 + c]; }
            __syncthreads();
        }
    }
    for (int rt_ = 0; rt_ < REP_PRO_T; ++rt_) {
        LAS float* scr = (LAS float*)(lds + wave * 8448);
        constexpr int I_IN = 16 * 112, I_O = 16 * 32, I_U = 16 * 128, I_D = 64 * 32, I_L = I_IN + I_O + I_U + I_D;
        for (int it = gw; it < DEPTH * I_L; it += NGW) {
            const int l = it / I_L; int r = it % I_L;
            unsigned char* wl = ws + WS_W + (size_t)l * W_LAYER;
            if (r < I_IN) { const int kb = r / 112, nb = r % 112; tr_load(a.in[3] + (size_t)l * D * NIN, NIN, 64 * kb, 32 * nb, scr, lane);
                tr_store_win((bf16*)(wl + W_T1), (bf16*)(wl + W_T2), 64 * kb, 32 * nb, scr, lane); LDS_WAIT(); asm volatile("" ::: "memory"); continue; } r -= I_IN;
            if (r < I_O) { const int kb = r / 32, nb = r % 32; tr_load(a.in[6] + (size_t)l * D * D, D, 64 * kb, 32 * nb, scr, lane);
                tr_store_plain((bf16*)(wl + W_O), D, 64 * kb, 32 * nb, scr, lane); LDS_WAIT(); asm volatile("" ::: "memory"); continue; } r -= I_O;
            if (r < I_U) { const int kb = r / 128, nb = r % 128; tr_load(a.in[8] + (size_t)l * D * FF, FF, 64 * kb, 32 * nb, scr, lane);
                tr_store_plain((bf16*)(wl + W_U), D, 64 * kb, 32 * nb, scr, lane); LDS_WAIT(); asm volatile("" ::: "memory"); continue; } r -= I_U;
            { const int kb = r / 32, nb = r % 32; tr_load(a.in[9] + (size_t)l * FF * D, D, 64 * kb, 32 * nb, scr, lane);
                tr_store_plain((bf16*)(wl + W_D), FF, 64 * kb, 32 * nb, scr, lane); LDS_WAIT(); asm volatile("" ::: "memory"); }
        }
    }
}

__device__ __forceinline__ void norm_mod_phase(const float* x, const float* x0src, size_t x0stride, float* h0buf, const float* g, const float* sh, const float* sc, bf16* XN, int gw, int NGW, int lane) {
    const int wpb = NGW / BATCH, rpw = T / wpb;
    const int b = gw / wpb, wi = gw - b * wpb;
    f32x4 gm[4], s0[4];
#pragma unroll
    for (int j = 0; j < 4; ++j) { const int col = 4 * lane + 256 * j; gm[j] = *(const f32x4*)(g + col) * (*(const f32x4*)(sc + b * NMOD + col) + 1.f); s0[j] = *(const f32x4*)(sh + b * NMOD + col); }
    for (int k = 0; k < rpw; k += 4) {
        f32x4 v[4][4];
#pragma unroll
        for (int r = 0; r < 4; ++r) { const int t = wi + wpb * (k + r); const bool t0 = t == 0;
            const f32x4* xr = (const f32x4*)(t0 ? x0src + (size_t)b * x0stride : x + ((size_t)b * T + t) * D) + lane;
#pragma unroll
            for (int j = 0; j < 4; ++j) v[r][j] = xr[64 * j]; }
        __builtin_amdgcn_sched_barrier(0);
#pragma unroll
        for (int r = 0; r < 4; ++r) { const int t = wi + wpb * (k + r); const bool t0 = t == 0; const size_t row = (size_t)b * T + t;
            float ss = 0.f;
#pragma unroll
            for (int j = 0; j < 4; ++j) ss += (v[r][j].x * v[r][j].x + v[r][j].y * v[r][j].y) + (v[r][j].z * v[r][j].z + v[r][j].w * v[r][j].w);
            const float rstd = 1.f / sqrtf(wave_sum(ss) * (1.f / D) + EPS);
#pragma unroll
            for (int j = 0; j < 4; ++j) { const int col = 4 * lane + 256 * j;
                const f32x4 h = v[r][j] * rstd * gm[j] + s0[j];
                v2u o; o.x = pk2(h.x, h.y); o.y = pk2(h.z, h.w);
                *(v2u*)(XN + row * D + col) = o;
                if (t0) *(f32x4*)(h0buf + b * D + col) = h; } }
    }
}
__device__ __forceinline__ void final_norm_phase(float* x, const float* x0buf, const float* g, int gw, int NGW, int lane) {
    f32x4 gg[4];
#pragma unroll
    for (int j = 0; j < 4; ++j) gg[j] = *(const f32x4*)(g + 4 * lane + 256 * j);
    for (int row0 = gw; row0 < M; row0 += 4 * NGW) {
        f32x4 v[4][4];
#pragma unroll
        for (int r = 0; r < 4; ++r) { const int row = row0 + r * NGW; const bool t0 = (row & 4095) == 0;
            const f32x4* xs = t0 ? (const f32x4*)(x0buf + (size_t)(row >> 12) * D) + lane : (const f32x4*)(x + (size_t)row * D) + lane;
#pragma unroll
            for (int j = 0; j < 4; ++j) v[r][j] = xs[64 * j]; }
        __builtin_amdgcn_sched_barrier(0);
#pragma unroll
        for (int r = 0; r < 4; ++r) { const int row = row0 + r * NGW; f32x4* xr = (f32x4*)(x + (size_t)row * D) + lane;
            float ss = 0.f;
#pragma unroll
            for (int j = 0; j < 4; ++j) ss += (v[r][j].x * v[r][j].x + v[r][j].y * v[r][j].y) + (v[r][j].z * v[r][j].z + v[r][j].w * v[r][j].w);
            const float rstd = 1.f / sqrtf(wave_sum(ss) * (1.f / D) + EPS);
#pragma unroll
            for (int j = 0; j < 4; ++j) xr[64 * j] = v[r][j] * rstd * gg[j]; }
    }
}
template <int MODE, int COLS>
__device__ __forceinline__ void chain_gemv(LAS unsigned char* lds, const float* W, int K, int N, const float* in, float* out, const float* base, size_t bstride, const float* gate, int bid, int G, int tid, int lane, int wave) {
    constexpr int KS = 64 / COLS;
    const int nitem = N / COLS;
    if (bid >= nitem) return;
    const int Kw = K >> 3, k0 = wave * Kw, col = lane & (COLS - 1), ksub = lane / COLS;
    LAS float* lin = (LAS float*)lds + wave * (8 * Kw);
    LAS float* red = (LAS float*)(lds + 131072 + 256);
    for (int b = 0; b < 8; ++b) for (int kk = lane; kk < Kw; kk += 64) lin[b * Kw + kk] = in[(size_t)b * K + k0 + kk];
    LDS_WAIT(); asm volatile("" ::: "memory");
    const bool swz = (G == 256 && nitem == 256);
    for (int it = bid; it < nitem; it += G) {
        const int item = swz ? (it & 7) * 32 + (it >> 3) : it;
        const float* Wp = W + (size_t)(k0 + ksub) * N + item * COLS + col;
        float acc[8];
#pragma unroll
        for (int b = 0; b < 8; ++b) acc[b] = 0.f;
        const int nj = Kw / KS;
        constexpr int JB = (COLS == 16) ? 32 : 8;
        for (int j0 = 0; j0 < nj; j0 += JB) {
            float wv[JB];
#pragma unroll
            for (int j = 0; j < JB; ++j) wv[j] = Wp[(size_t)(KS * (j0 + j)) * N];
#pragma unroll
            for (int j = 0; j < JB; ++j)
#pragma unroll
                for (int b = 0; b < 8; ++b) acc[b] += lin[b * Kw + KS * (j0 + j) + ksub] * wv[j];
        }
#pragma unroll
        for (int b = 0; b < 8; ++b) {
#pragma unroll
            for (int o = COLS; o < 64; o <<= 1) acc[b] += __shfl_xor(acc[b], o); }
        if (ksub == 0) {
#pragma unroll
            for (int b = 0; b < 8; ++b) red[(wave * 8 + b) * COLS + col] = acc[b]; }
        __syncthreads();
        if (tid < 8 * COLS) { const int b = tid / COLS, c = tid & (COLS - 1), n = item * COLS + c; float s = 0.f;
#pragma unroll
            for (int w = 0; w < 8; ++w) s += red[(w * 8 + b) * COLS + c];
            if (MODE == 0) out[(size_t)b * N + n] = s;
            else if (MODE == 2) { const float r = fmaxf(s, 0.f); out[(size_t)b * N + n] = r * r; }
            else out[(size_t)b * N + n] = base[(size_t)b * bstride + n] + gate[b * NMOD + n] * s; }
        __syncthreads();
    }
}
__device__ __forceinline__ void chain_mixer(const float* proj0, const float* cw, const float* retg, float* y0, int wave, int lane) {
    const float* p = proj0 + wave * NIN; float* y = y0 + wave * D;
    float pv[56], cwv[8], rg[8];
#pragma unroll
    for (int i = 0; i < 56; ++i) pv[i] = p[lane + 64 * i];
#pragma unroll
    for (int i = 0; i < 8; ++i) { cwv[i] = cw[1024 + lane + 64 * i]; rg[i] = retg[lane + 64 * i]; }
    __builtin_amdgcn_sched_barrier(0);
#pragma unroll
    for (int i = 0; i < 8; ++i) y[lane + 64 * i] = pv[i] * (cwv[i] * (pv[8 + i] * pv[16 + i]));
#pragma unroll
    for (int h = 0; h < NHEAD; ++h) {
        const float q0 = pv[24 + 2 * h], q1 = pv[25 + 2 * h], k0 = pv[32 + 2 * h], k1 = pv[33 + 2 * h], v0 = pv[40 + 2 * h], v1 = pv[41 + 2 * h], g0 = pv[48 + 2 * h], g1 = pv[49 + 2 * h];
        const float score = wave_sum(q0 * k0 + q1 * k1) * 0.08838834764831845f;
        const float o0 = score * v0, o1 = score * v1;
        const float mu = wave_sum(o0 + o1) * (1.f / 128.f);
        const float d0 = o0 - mu, d1 = o1 - mu;
        const float rstd = 1.f / sqrtf(wave_sum(d0 * d0 + d1 * d1) * (1.f / 128.f) + EPS);
        y[512 + h * 128 + lane] = (g0 / (1.f + __expf(-g0))) * (d0 * rstd * rg[2 * h]);
        y[512 + h * 128 + lane + 64] = (g1 / (1.f + __expf(-g1))) * (d1 * rstd * rg[2 * h + 1]);
    }
}

#define MFMA16(a, b, c) __builtin_amdgcn_mfma_f32_16x16x32_bf16(a, b, c, 0, 0, 0)
__device__ __forceinline__ void ret_scan_phase(const bf16* KVT, bf16* ST, const float* cdtab, int bid, int G, int wave, int lane) {
    const int fr = lane & 15, fq = lane >> 4;
    for (int unit = bid; unit < 256; unit += G) {
        const int bh = (unit & 7) * 4 + (unit >> 6), es = (unit >> 3) & 7, h = bh & 3, b = bh >> 2;
        const float cd = cdtab[h];
        const bf16* kp0 = KVT + (size_t)(h * 128 + 16 * wave + fr) * KVT_LD + (size_t)b * T + 8 * fq;
        const bf16* kp1 = kp0 + (size_t)64 * KVT_LD;
        const bf16* vp = KVT + (size_t)(512 + h * 128 + 16 * es + fr) * KVT_LD + (size_t)b * T + 8 * fq;
        bf16* sp = ST + (size_t)((b * 4 + h) * NCH) * 16384 + (16 * es + fr) * 128 + 16 * wave + 4 * fq;
        f32x4 acc0 = {0.f, 0.f, 0.f, 0.f}, acc1 = {0.f, 0.f, 0.f, 0.f};
        bf16x8 x0[2][4], x1[2][4], ys[2][4];
#pragma unroll
        for (int s = 0; s < 2; ++s)
#pragma unroll
            for (int kk = 0; kk < 4; ++kk) { x0[s][kk] = *(const bf16x8*)(kp0 + s * 128 + 32 * kk); x1[s][kk] = *(const bf16x8*)(kp1 + s * 128 + 32 * kk); ys[s][kk] = *(const bf16x8*)(vp + s * 128 + 32 * kk); }
        for (int n = 0; n < NCH; n += 2) {
#pragma unroll
            for (int s = 0; s < 2; ++s) {
                { v2u o; o.x = pk2(acc0[0], acc0[1]); o.y = pk2(acc0[2], acc0[3]); *(v2u*)(sp + (size_t)(n + s) * 16384) = o;
                  o.x = pk2(acc1[0], acc1[1]); o.y = pk2(acc1[2], acc1[3]); *(v2u*)(sp + (size_t)(n + s) * 16384 + 64) = o; }
#pragma unroll
                for (int kk = 0; kk < 4; ++kk) { acc0 = MFMA16(x0[s][kk], ys[s][kk], acc0); acc1 = MFMA16(x1[s][kk], ys[s][kk], acc1); }
                acc0 = acc0 * cd; acc1 = acc1 * cd;
                if (n + 2 < NCH) {
#pragma unroll
                    for (int kk = 0; kk < 4; ++kk) { x0[s][kk] = *(const bf16x8*)(kp0 + (n + s + 2) * 128 + 32 * kk); x1[s][kk] = *(const bf16x8*)(kp1 + (n + s + 2) * 128 + 32 * kk); ys[s][kk] = *(const bf16x8*)(vp + (n + s + 2) * 128 + 32 * kk); }
                }
            }
        }
    }
}
__device__ __forceinline__ void conv_phase(const bf16* P1, const float* cw, bf16* Y, int gw, int NGW, int lane) {
    float w0[8], w1[8], w2[8];
#pragma unroll
    for (int k = 0; k < 8; ++k) { w0[k] = cw[8 * lane + k]; w1[k] = cw[512 + 8 * lane + k]; w2[k] = cw[1024 + 8 * lane + k]; }
    for (int run = gw; run < M / 16; run += NGW) {
        const int tok0 = run * 16, t0 = tok0 & 4095;
        float z1[8], z2[8];
#pragma unroll
        for (int k = 0; k < 8; ++k) { z1[k] = 0.f; z2[k] = 0.f; }
        if (t0 != 0) {
            const bf16* r2 = P1 + (size_t)(tok0 - 2) * N1 + 8 * lane; const bf16* r1 = r2 + N1;
            const v4u c2 = *(const v4u*)(r2 + 512), c1 = *(const v4u*)(r1 + 512);
#pragma unroll
            for (int k = 0; k < 4; ++k) { z2[2 * k] = bflo(c2[k]); z2[2 * k + 1] = bfhi(c2[k]); z1[2 * k] = bflo(c1[k]); z1[2 * k + 1] = bfhi(c1[k]); }
        }
        for (int i0 = 0; i0 < 16; i0 += 8) {
            v4u bbv[8], ccv[8];
#pragma unroll
            for (int i = 0; i < 8; ++i) { const bf16* r = P1 + (size_t)(tok0 + i0 + i) * N1 + 8 * lane; bbv[i] = *(const v4u*)r; ccv[i] = *(const v4u*)(r + 512); }
            __builtin_amdgcn_sched_barrier(0);
#pragma unroll
            for (int i = 0; i < 8; ++i) {
                const v4u bb = bbv[i], cc = ccv[i];
                float z0[8], y[8];
#pragma unroll
                for (int k = 0; k < 4; ++k) { z0[2 * k] = bflo(cc[k]); z0[2 * k + 1] = bfhi(cc[k]); }
#pragma unroll
                for (int k = 0; k < 4; ++k) {
                    y[2 * k] = bflo(bb[k]) * (w0[2 * k] * z2[2 * k] + w1[2 * k] * z1[2 * k] + w2[2 * k] * z0[2 * k]);
                    y[2 * k + 1] = bfhi(bb[k]) * (w0[2 * k + 1] * z2[2 * k + 1] + w1[2 * k + 1] * z1[2 * k + 1] + w2[2 * k + 1] * z0[2 * k + 1]);
                }
                v4u o; o.x = pk2(y[0], y[1]); o.y = pk2(y[2], y[3]); o.z = pk2(y[4], y[5]); o.w = pk2(y[6], y[7]);
                *(v4u*)(Y + (size_t)(tok0 + i0 + i) * D + 8 * lane) = o;
#pragma unroll
                for (int k = 0; k < 8; ++k) { z2[k] = z1[k]; z1[k] = z0[k]; }
            }
            __builtin_amdgcn_sched_barrier(0);
        }
    }
}
__device__ __forceinline__ void ret_out_phase(const bf16* P1, const bf16* KVT, const bf16* ST, const float* retg, bf16* Y, LAS unsigned char* lds, int bid, int G, int tid, int wave, int lane) {
    constexpr int NU = BATCH * NHEAD * NCH, PITCH = 272, TILE = 128 * PITCH;
    const int fr = lane & 15, fq = lane >> 4;
    LAS unsigned char* lS = lds; LAS unsigned char* lK = lds + TILE; LAS unsigned char* lV = lds + 2 * TILE;
    v4u pS[4], pK[4], pV[4]; bf16x8 qn[4]; v2u gn[8];
#define R2_ISSUE(unit_, w_) do { const int n_ = (unit_) & 31, h_ = ((unit_) >> 5) & 3, b_ = (unit_) >> 7; const size_t tok0_ = (size_t)b_ * T + 128 * n_; \
        _Pragma("unroll") for (int i = 0; i < 4; ++i) { const int idx = tid + NTHR * i, r = idx >> 4, c = idx & 15; \
            pS[i] = *(const v4u*)(ST + (size_t)(unit_) * 16384 + r * 128 + c * 8); \
            pK[i] = *(const v4u*)(P1 + (tok0_ + r) * N1 + 2048 + h_ * 128 + c * 8); \
            pV[i] = *(const v4u*)(KVT + (size_t)(512 + h_ * 128 + r) * KVT_LD + tok0_ + c * 8); } \
        const bf16* qr_ = P1 + (tok0_ + 16 * (w_) + fr) * N1 + h_ * 128; \
        _Pragma("unroll") for (int kd = 0; kd < 4; ++kd) qn[kd] = *(const bf16x8*)(qr_ + 1536 + 8 * fq + 32 * kd); \
        _Pragma("unroll") for (int te = 0; te < 8; ++te) gn[te] = *(const v2u*)(qr_ + 2560 + 4 * fq + 16 * te); } while (0)
#define R2_WRITE() do { _Pragma("unroll") for (int i = 0; i < 4; ++i) { const int idx = tid + NTHR * i, r = idx >> 4, c = idx & 15; \
            *(LAS v4u*)(lS + r * PITCH + c * 16) = pS[i]; *(LAS v4u*)(lK + r * PITCH + c * 16) = pK[i]; *(LAS v4u*)(lV + r * PITCH + c * 16) = pV[i]; } } while (0)
    int uc = 0, unit = bid;
    if (unit < NU) { R2_ISSUE(unit, wave); R2_WRITE(); }
    __syncthreads();
    for (; unit < NU; unit += G, ++uc) {
        const int w = (uc & 1) ? 7 - wave : wave;
        const int n = unit & 31, h = (unit >> 5) & 3, b = unit >> 7;
        const size_t tok0 = (size_t)b * T + 128 * n;
        bf16x8 qf[4]; v2u gq[8];
#pragma unroll
        for (int kd = 0; kd < 4; ++kd) qf[kd] = qn[kd];
#pragma unroll
        for (int te = 0; te < 8; ++te) gq[te] = gn[te];
        const int nxt = unit + G; const bool has = nxt < NU;
        if (has) { const int wn = ((uc + 1) & 1) ? 7 - wave : wave; R2_ISSUE(nxt, wn); }
        __builtin_amdgcn_sched_barrier(0);
        f32x4 o[8];
#pragma unroll
        for (int te = 0; te < 8; ++te) o[te] = (f32x4){0.f, 0.f, 0.f, 0.f};
#pragma unroll
        for (int te = 0; te < 8; ++te)
#pragma unroll
            for (int kd = 0; kd < 4; ++kd) o[te] = MFMA16(*(const LAS bf16x8*)(lS + (16 * te + fr) * PITCH + kd * 64 + fq * 16), qf[kd], o[te]);
        const int nb = (w >> 1) + 1;
        for (int kk = 0; kk < nb; ++kk) {
            f32x4 sc[2];
#pragma unroll
            for (int t01 = 0; t01 < 2; ++t01) { sc[t01] = (f32x4){0.f, 0.f, 0.f, 0.f};
                const LAS unsigned char* kr = lK + (32 * kk + 8 * (fr >> 2) + (fr & 3) + 4 * t01) * PITCH + fq * 16;
#pragma unroll
                for (int kd = 0; kd < 4; ++kd) sc[t01] = MFMA16(*(const LAS bf16x8*)(kr + kd * 64), qf[kd], sc[t01]); }
            if (kk == nb - 1) { const int i = 16 * w + fr;
#pragma unroll
                for (int t01 = 0; t01 < 2; ++t01)
#pragma unroll
                    for (int r = 0; r < 4; ++r) { const int j = 32 * kk + 8 * fq + 4 * t01 + r; if (j > i) sc[t01][r] = 0.f; } }
            v4u pw; pw.x = pk2(sc[0][0], sc[0][1]); pw.y = pk2(sc[0][2], sc[0][3]); pw.z = pk2(sc[1][0], sc[1][1]); pw.w = pk2(sc[1][2], sc[1][3]);
            const bf16x8 pf = __builtin_bit_cast(bf16x8, pw);
#pragma unroll
            for (int te = 0; te < 8; ++te) o[te] = MFMA16(*(const LAS bf16x8*)(lV + (16 * te + fr) * PITCH + kk * 64 + fq * 16), pf, o[te]);
        }
        float s = 0.f;
#pragma unroll
        for (int te = 0; te < 8; ++te) s += (o[te][0] + o[te][1]) + (o[te][2] + o[te][3]);
        s += __shfl_xor(s, 16); s += __shfl_xor(s, 32);
        const float mean = s * (1.f / 128.f); float q = 0.f;
#pragma unroll
        for (int te = 0; te < 8; ++te) { const f32x4 dlt = o[te] - mean; q += (dlt[0] * dlt[0] + dlt[1] * dlt[1]) + (dlt[2] * dlt[2] + dlt[3] * dlt[3]); }
        q += __shfl_xor(q, 16); q += __shfl_xor(q, 32);
        const float rstd = 1.f / sqrtf(q * (1.f / 128.f) + EPS);
        bf16* yrow = Y + (tok0 + 16 * w + fr) * D + 512 + h * 128 + 4 * fq;
        const float* gg = retg + h * 128 + 4 * fq;
#pragma unroll
        for (int te = 0; te < 8; ++te) {
            const v2u gw2 = gq[te]; const f32x4 g4 = *(const f32x4*)(gg + 16 * te);
            float gv[4] = {bflo(gw2.x), bfhi(gw2.x), bflo(gw2.y), bfhi(gw2.y)}; float y[4];
#pragma unroll
            for (int r = 0; r < 4; ++r) { const float sl = gv[r] / (1.f + __expf(-gv[r])); y[r] = (o[te][r] - mean) * rstd * g4[r] * sl; }
            v2u ov; ov.x = pk2(y[0], y[1]); ov.y = pk2(y[2], y[3]);
            *(v2u*)(yrow + 16 * te) = ov;
        }
        __syncthreads();
        if (has) R2_WRITE();
        __syncthreads();
    }
#undef R2_ISSUE
#undef R2_WRITE
}

#define XB_TMO      128
#define XB_XCNT(j)  (256  + 64 * (j))
#define XB_XSUB(j)  (1280 + 64 * (j))
#define XB_XGEN(j)  (2304 + 64 * (j))
#define XB_TOP      3328
#define XB_TOPGEN   3392
#define XCD_BAR_WORDS 3456
#define XB_SPIN_CAP (1u << 18)

__device__ __forceinline__ unsigned xb_ld(unsigned* p)              { return __hip_atomic_load(p, __ATOMIC_RELAXED, __HIP_MEMORY_SCOPE_AGENT); }
__device__ __forceinline__ unsigned xb_add(unsigned* p, unsigned v) { return __hip_atomic_fetch_add(p, v, __ATOMIC_RELAXED, __HIP_MEMORY_SCOPE_AGENT); }
__device__ __forceinline__ unsigned xb_xcc_id() { return (unsigned)__builtin_amdgcn_s_getreg((3 << 11) | 20) & 0xFu; }
#define XB_SPIN(cond, bar) do { unsigned _sp = 0; while (cond) { __builtin_amdgcn_s_sleep(1); \
    if ((++_sp & 255u) == 0u) { if (xb_ld(&(bar)[XB_TMO])) break; if (_sp > XB_SPIN_CAP) { atomicAdd(&(bar)[XB_TMO], 1u); break; } } } } while (0)

struct XcdBarrier {
    unsigned* bar; unsigned x;
    volatile LAS unsigned* st;
};

__device__ __forceinline__ XcdBarrier xcd_barrier_post(unsigned* bar, volatile LAS unsigned* st) {
    XcdBarrier b; b.bar = bar; b.x = xb_xcc_id(); b.st = st;
    if (threadIdx.x == 0) (void)xb_add(&bar[XB_XCNT(b.x)], 1u);
    return b;
}
__device__ __forceinline__ void xcd_barrier_complete(unsigned* bar, unsigned x, unsigned& nloc, unsigned& nx) {
    const unsigned G = gridDim.x * gridDim.y * gridDim.z;
    unsigned sum, cnt, mine, sp = 0u;
    for (;;) {
        sum = 0u; cnt = 0u; mine = 0u;
#pragma unroll
        for (unsigned j = 0; j < 16; ++j) { const unsigned c = xb_ld(&bar[XB_XCNT(j)]); sum += c; cnt += (c > 0u) ? 1u : 0u; mine = (j == x) ? c : mine; }
        if (sum == G) break;
        __builtin_amdgcn_s_sleep(1);
        if ((++sp & 255u) == 0u) { if (xb_ld(&bar[XB_TMO])) break; if (sp > XB_SPIN_CAP) { atomicAdd(&bar[XB_TMO], 1u); break; } }
    }
    nloc = mine > 0u ? mine : 1u; nx = cnt > 0u ? cnt : 1u;
}

__device__ __forceinline__ void xcd_barrier(const XcdBarrier& b) {
    asm volatile("s_waitcnt vmcnt(0)" ::: "memory");
    __syncthreads();
    if (threadIdx.x == 0) {
        unsigned* bar = b.bar;
        __builtin_amdgcn_s_waitcnt(0);
        unsigned nloc = b.st[0], nx = b.st[1];
        if (nloc == 0u) { xcd_barrier_complete(bar, b.x, nloc, nx); b.st[0] = nloc; b.st[1] = nx; }
        const unsigned old = xb_add(&bar[XB_XSUB(b.x)], 1u);
        const unsigned gen = old / nloc;
        if (old + 1u == (gen + 1u) * nloc) {
            __builtin_amdgcn_fence(__ATOMIC_RELEASE, "agent");
            asm volatile("s_waitcnt vmcnt(0)" ::: "memory");
            const unsigned og = xb_add(&bar[XB_TOP], 1u);
            const unsigned tg = og / nx;
            if (og + 1u == (tg + 1u) * nx) xb_add(&bar[XB_TOPGEN], 1u);
            else XB_SPIN(xb_ld(&bar[XB_TOPGEN]) == tg, bar);
            __builtin_amdgcn_fence(__ATOMIC_ACQUIRE, "agent");
            xb_add(&bar[XB_XGEN(b.x)], 1u);
            asm volatile("s_waitcnt vmcnt(0)" ::: "memory");
        } else {
            XB_SPIN(xb_ld(&bar[XB_XGEN(b.x)]) == gen, bar);
            __builtin_amdgcn_fence(__ATOMIC_ACQUIRE, "agent");
            asm volatile("s_waitcnt vmcnt(0)" ::: "memory");
        }
    }
    __syncthreads();
}

__device__ __forceinline__ unsigned long long tab_get(int k, LAS unsigned char* lds) {
    const LAS unsigned* t = (const LAS unsigned*)(lds + 131072) + 2 * k;
    const unsigned lo = __builtin_amdgcn_readfirstlane(t[0]), hi = __builtin_amdgcn_readfirstlane(t[1]);
    return ((unsigned long long)hi << 32) | lo;
}
__global__ void __launch_bounds__(NTHR, 2) fwd_kernel(Args a) {
    extern __shared__ __attribute__((aligned(16))) unsigned char lds_raw[];
    cg::grid_group grid = cg::this_grid();
    LAS unsigned char* lds = (LAS unsigned char*)lds_raw;
    const int lo = a.ph_lo, hi = a.ph_hi; int ph = 0;
    if (threadIdx.x == 0) {
        LAS unsigned long long* t = (LAS unsigned long long*)(lds + 131072);
#pragma unroll
        for (int i = 0; i < 13; ++i) t[i] = (unsigned long long)a.in[i];
        t[13] = (unsigned long long)a.out; t[14] = (unsigned long long)a.ws;
        ((LAS unsigned*)(lds + 131072 + 128))[0] = 0u; ((LAS unsigned*)(lds + 131072 + 128))[1] = 0u;
    }
    if (blockIdx.x == 0) { unsigned* bw = (unsigned*)(a.ws + WS_BAR); for (int i = threadIdx.x; i < XCD_BAR_WORDS; i += NTHR) bw[i] = 0u; }
    __syncthreads();
#define GASP __attribute__((address_space(1)))
#define IN(k) ((const float*)(const GASP float*)tab_get((k), lds))
#define XO() ((float*)(GASP float*)tab_get(13, lds))
#define WS() ((unsigned char*)(GASP unsigned char*)tab_get(14, lds))
#define RUN(k) (lo <= (k) && (k) < hi)
#define BG() int bid = blockIdx.x, G = gridDim.x; asm volatile("" : "+s"(bid), "+s"(G))
#define LT() BG(); const int NGW = G * NWAVES; int tid = threadIdx.x; asm volatile("" : "+v"(tid)); const int lane = tid & 63, wave = __builtin_amdgcn_readfirstlane(tid >> 6), gw = bid * NWAVES + wave; (void)lane; (void)gw; (void)NGW
#define SEAM() do { ++ph; if (lo < ph && ph < hi) { \
    if (ph == 1 || MK_CG_ONLY) { asm volatile("s_waitcnt vmcnt(0) lgkmcnt(0)" ::: "memory"); __syncthreads();   \
        if (threadIdx.x == 0) { __builtin_amdgcn_fence(__ATOMIC_RELEASE, "agent"); asm volatile("s_waitcnt vmcnt(0)" ::: "memory"); }   \
        for (int xs_ = 0; xs_ < 1 + XSYNC; ++xs_) grid.sync(); \
        if (threadIdx.x == 0) { __builtin_amdgcn_fence(__ATOMIC_ACQUIRE, "agent"); asm volatile("s_waitcnt vmcnt(0)" ::: "memory"); } __syncthreads(); \
        if (!MK_CG_ONLY) (void)xcd_barrier_post((unsigned*)(WS() + WS_BAR), (volatile LAS unsigned*)(lds + 131072 + 128)); } \
    else { XcdBarrier xb_; xb_.bar = (unsigned*)(WS() + WS_BAR); xb_.x = xb_xcc_id(); xb_.st = (volatile LAS unsigned*)(lds + 131072 + 128); \
        for (int xs_ = 0; xs_ < 1 + XSYNC; ++xs_) xcd_barrier(xb_); } } } while (0)

#if defined(MK_NANFILL) && MK_NANFILL
    if (RUN(ph)) { LT(); unsigned char* ws = WS(); v4u* p = (v4u*)(ws + WS_COS); const size_t n16 = (WS_END - WS_COS) / 16; const v4u q = {0xffffffffu, 0xffffffffu, 0xffffffffu, 0xffffffffu};
        for (size_t i = (size_t)bid * NTHR + tid; i < n16; i += (size_t)G * NTHR) p[i] = q;
        { v4u* z = (v4u*)(ws + WS_MOD); const v4u zz = {0u, 0u, 0u, 0u}; for (size_t i = (size_t)bid * NTHR + tid; i < CTL_ZERO_BYTES / 16; i += (size_t)G * NTHR) z[i] = zz; }
        v4u* o = (v4u*)XO(); for (size_t i = (size_t)bid * NTHR + tid; i < (size_t)M * D / 4; i += (size_t)G * NTHR) o[i] = q; }
    SEAM();
#endif
    if (RUN(ph)) for (int rep_ = 0; rep_ < REP_PRO; ++rep_) { LT(); prologue(a, lds, tid, lane, wave, bid, G); }
    SEAM();
    for (int l = 0; l < DEPTH; ++l) {
        if (RUN(ph)) for (int rep_ = 0; rep_ < REP_NORM; ++rep_) { LT(); unsigned char* ws = WS(); const float* modl = (const float*)(ws + WS_MOD) + (size_t)l * 8 * NMOD;
            norm_mod_phase(l == 0 ? IN(0) : (const float*)XO(), l == 0 ? IN(0) : (const float*)(ws + CH_X0), l == 0 ? (size_t)T * D : (size_t)D, (float*)(ws + CH_H0), IN(2) + l * D, modl, modl + D, (bf16*)(ws + WS_XN), gw, NGW, lane); }
        SEAM();
        if (RUN(ph)) for (int rep_ = 0; rep_ < REP_GEMM_IN; ++rep_) {
            { BG(); unsigned char* ws = WS(); unsigned char* wl = ws + WS_W + (size_t)l * W_LAYER;
              static_assert(W_T2 == W_T1 + (size_t)N1 * D * 2, "the v weight rows continue Wt1");
              pg8::Gemm g{(const bf16*)(ws + WS_XN), (const bf16*)(wl + W_T1), M, NIN, D}; pg8::StaticOrder S; S.init(M, NIN, G, bid);
              pg8::EpiInProj E{(bf16*)(ws + WS_P1), (const float*)(ws + WS_COS), (const float*)(ws + WS_SIN), (const float*)(ws + WS_DQ), (const float*)(ws + WS_DK), (bf16*)(ws + WS_KVT), KVT_LD};
              pg8::gemm_phase<pg8::EpiInProj, pg8::StaticOrder, true, true>(lds, g, S, E); }
            { LT(); unsigned char* ws = WS(); chain_gemv<0, 16>(lds, IN(3) + (size_t)l * D * NIN, D, NIN, (const float*)(ws + CH_H0), (float*)(ws + CH_P0), nullptr, 0, nullptr, bid, G, tid, lane, wave); }
        }
        SEAM();
        if (RUN(ph)) for (int rep_ = 0; rep_ < REP_RET1; ++rep_) { LT(); unsigned char* ws = WS();
            if (wave < 4) ret_scan_phase((const bf16*)(ws + WS_KVT), (bf16*)(ws + WS_ST), (const float*)(ws + WS_DK) + 512, bid, G, wave, lane);
            else conv_phase((const bf16*)(ws + WS_P1), IN(4) + l * 3 * 512, (bf16*)(ws + WS_XN), bid * 4 + (wave - 4), G * 4, lane);
            if (bid == G - 1) chain_mixer((const float*)(ws + CH_P0), IN(4) + l * 3 * 512, IN(5) + l * 512, (float*)(ws + CH_Y0), wave, lane); }
        SEAM();
        if (RUN(ph)) for (int rep_ = 0; rep_ < REP_RET2; ++rep_) { LT(); unsigned char* ws = WS();
            ret_out_phase((const bf16*)(ws + WS_P1), (const bf16*)(ws + WS_KVT), (const bf16*)(ws + WS_ST), IN(5) + l * 512, (bf16*)(ws + WS_XN), lds, bid, G, tid, wave, lane); }
        SEAM();
        if (RUN(ph)) { BG(); unsigned char* ws = WS(); unsigned char* wl = ws + WS_W + (size_t)l * W_LAYER;
            const float* modl = (const float*)(ws + WS_MOD) + (size_t)l * 8 * NMOD;
            pg8::Gemm g{(const bf16*)(ws + WS_XN), (const bf16*)(wl + W_O), M, D, D}; pg8::StaticOrder S; S.init(M, D, G, bid);
            pg8::EpiRes E{l == 0 ? IN(0) : (const float*)XO(), XO(), modl + 2 * D};
            pg8::gemm_phase<pg8::EpiRes, pg8::StaticOrder, true, true>(lds, g, S, E);
            { LT(); unsigned char* ws = WS(); const float* modl = (const float*)(ws + WS_MOD) + (size_t)l * 8 * NMOD;
              chain_gemv<1, 4>(lds, IN(6) + (size_t)l * D * D, D, D, (const float*)(ws + CH_Y0), (float*)(ws + CH_X0), l == 0 ? IN(0) : (const float*)(ws + CH_X0), l == 0 ? (size_t)T * D : (size_t)D, modl + 2 * D, bid, G, tid, lane, wave); } }
        SEAM();
        if (RUN(ph)) for (int rep_ = 0; rep_ < REP_NORM; ++rep_) { LT(); unsigned char* ws = WS(); const float* modl = (const float*)(ws + WS_MOD) + (size_t)l * 8 * NMOD;
            norm_mod_phase(XO(), (const float*)(ws + CH_X0), (size_t)D, (float*)(ws + CH_H0), IN(7) + l * D, modl + 3 * D, modl + 4 * D, (bf16*)(ws + WS_XN), gw, NGW, lane); }
        SEAM();
        if (RUN(ph)) for (int rep_ = 0; rep_ < REP_GEMM_UP; ++rep_) { BG(); unsigned char* ws = WS(); unsigned char* wl = ws + WS_W + (size_t)l * W_LAYER;
            pg8::Gemm g{(const bf16*)(ws + WS_XN), (const bf16*)(wl + W_U), M, FF, D}; pg8::StaticOrder S; S.init(M, FF, G, bid);
            pg8::EpiRelu2 E{(bf16*)(ws + WS_H), FF};
            pg8::gemm_phase<pg8::EpiRelu2, pg8::StaticOrder, true, true>(lds, g, S, E);
            { LT(); unsigned char* ws = WS(); chain_gemv<2, 16>(lds, IN(8) + (size_t)l * D * FF, D, FF, (const float*)(ws + CH_H0), (float*)(ws + CH_U0), nullptr, 0, nullptr, bid, G, tid, lane, wave); } }
        SEAM();
        if (RUN(ph)) { BG(); unsigned char* ws = WS(); unsigned char* wl = ws + WS_W + (size_t)l * W_LAYER;
            const float* modl = (const float*)(ws + WS_MOD) + (size_t)l * 8 * NMOD;
            pg8::Gemm g{(const bf16*)(ws + WS_H), (const bf16*)(wl + W_D), M, D, FF}; pg8::StaticOrder S; S.init(M, D, G, bid);
            pg8::EpiRes E{XO(), XO(), modl + 5 * D};
            pg8::gemm_phase<pg8::EpiRes, pg8::StaticOrder, true, true>(lds, g, S, E);
            { LT(); unsigned char* ws = WS(); const float* modl = (const float*)(ws + WS_MOD) + (size_t)l * 8 * NMOD;
              chain_gemv<1, 4>(lds, IN(9) + (size_t)l * FF * D, FF, D, (const float*)(ws + CH_U0), (float*)(ws + CH_X0), (const float*)(ws + CH_X0), (size_t)D, modl + 5 * D, bid, G, tid, lane, wave); } }
        SEAM();
    }
    if (RUN(ph)) { LT(); final_norm_phase(XO(), (const float*)(WS() + CH_X0), IN(12), gw, NGW, lane); }
#undef RUN
#undef SEAM
}

extern "C" void kernel_launch(void* const* d_in, const int* in_sizes, int n_in, void* d_out, int out_size, void* d_ws, size_t ws_size, hipStream_t stream) {
    static int grid = 0;
    if (grid == 0) {
        if (n_in != 13 || in_sizes[0] != M * D || out_size != M * D || ws_size < WS_END) { fprintf(stderr, "kernel_launch: unexpected shapes (n_in %d, in0 %d, out %d, ws %zu < %zu)\n", n_in, n_in > 0 ? in_sizes[0] : -1, out_size, ws_size, (size_t)WS_END); grid = -1; return; }
        int dev = 0, cus = 0, per_cu = 0;
        hipGetDevice(&dev); hipDeviceGetAttribute(&cus, hipDeviceAttributeMultiprocessorCount, dev);
        if (hipFuncSetAttribute((const void*)fwd_kernel, hipFuncAttributeMaxDynamicSharedMemorySize, LDS_BYTES) != hipSuccess) { fprintf(stderr, "kernel_launch: hipFuncSetAttribute failed\n"); grid = -1; return; }
        if (hipOccupancyMaxActiveBlocksPerMultiprocessor(&per_cu, (const void*)fwd_kernel, NTHR, LDS_BYTES) != hipSuccess || per_cu < 1) { fprintf(stderr, "kernel_launch: occupancy query gives %d\n", per_cu); per_cu = 1; }
        (void)hipGetLastError();
        grid = cus * per_cu;
    }
    if (grid < 0) return;
    Args a{};
    for (int i = 0; i < 13; ++i) a.in[i] = (const float*)d_in[i];
    a.out = (float*)d_out; a.ws = (unsigned char*)d_ws; a.ph_lo = 0; a.ph_hi = 1 << 20;
#if defined(MK_PER_PHASE) && MK_PER_PHASE
    for (int k = 0; k < 2 + MK_NANFILL + 8 * DEPTH; ++k) { a.ph_lo = k; a.ph_hi = k + 1; hipLaunchKernelGGL(fwd_kernel, dim3(grid), dim3(NTHR), LDS_BYTES, stream, a); }
#else
    void* args[] = {&a};
    hipError_t e = hipLaunchCooperativeKernel((const void*)fwd_kernel, dim3(grid), dim3(NTHR), args, LDS_BYTES, stream);
    if (e != hipSuccess) fprintf(stderr, "kernel_launch: cooperative launch failed: %s (grid %d)\n", hipGetErrorString(e), grid);
#endif
}
```

```cpp
#include <hip/hip_runtime.h>
#include <hip/hip_cooperative_groups.h>
#include <cstdio>
#include <cstdint>
namespace cg = cooperative_groups;
namespace pg8 {
#define PG8_LAS __attribute__((address_space(3)))
typedef unsigned short bf16_t;
typedef short bf16x8 __attribute__((ext_vector_type(8)));
typedef float f32x4 __attribute__((ext_vector_type(4)));
typedef unsigned u32x4 __attribute__((ext_vector_type(4)));
constexpr int BM = 256, BK = 64, HALF = 128, HTB = HALF * BK * 2  , STAGE_BYTES = 8 * HTB, NXCD = 8, WGM = 4;

__host__ __device__ __forceinline__ int lds_byte(int r, int c) { const int st = (r >> 4) * 2 + (c >> 5), rr = r & 15, cc = c & 31, ob = rr * 64 + cc * 2; return st * 1024 + (ob ^ (((ob >> 9) & 1) << 5)); }
__host__ __device__ __forceinline__ void stage_rc(int b, int& R, int& C) { const int st = b / 1024, sb = b % 1024, swz = sb ^ (((sb >> 9) & 1) << 5); R = (st >> 1) * 16 + swz / 64; C = (st & 1) * 32 + (swz % 64) / 2; }
__host__ __device__ __forceinline__ int perm32(int rho) { const int n = rho >> 4, i = rho & 15; return 8 * (i >> 2) + 4 * n + (i & 3); }

struct Unit { int pm, pn; };
struct Gemm { const bf16_t* A; const bf16_t* Bt; int M, N, K; };

struct StaticOrder {
    int nM, nN, nwg, G, c;
    __host__ __device__ void init(int M, int N, int G_, int c_) { nM = M / BM; nN = N / BM; nwg = nM * nN; G = G_; c = c_; }
    __host__ __device__ bool next(int i, Unit& u) const {
        const long L = (long)i * G + c; if (L >= nwg) return false;
        int wgid = (int)L; { const int q = nwg / NXCD, r = nwg % NXCD, xcd = wgid % NXCD, off = wgid / NXCD; wgid = (xcd < r ? xcd * (q + 1) : r * (q + 1) + (xcd - r) * q) + off; }
        const int nig = WGM * nN, gid = wgid / nig, fm = gid * WGM, gsz = (nM - fm) < WGM ? (nM - fm) : WGM;
        u.pm = fm + ((wgid % nig) % gsz); u.pn = (wgid % nig) / gsz; return true;
    }
    __device__ __forceinline__ void a_ready(const Unit&) const {}
    __device__ __forceinline__ void done(const Unit&) const {}
};

__device__ __forceinline__ unsigned cvt_pk_bf16(float lo, float hi) { unsigned r; asm volatile("v_cvt_pk_bf16_f32 %0, %1, %2" : "=v"(r) : "v"(lo), "v"(hi)); return r; }
typedef unsigned u32x2 __attribute__((ext_vector_type(2)));
struct EpiInProj {
    static constexpr bool PERM = true, AFTER_DRAIN = false;
    bf16_t* O; const float* cs; const float* sn; const float* dq; const float* dk;
    bf16_t* KT; int ldk;
    __device__ __forceinline__ void operator()(const f32x4 (&acc)[2][2][4][2], const Unit& u, int wr, int wc, int fr, int fq) const {
        const int row0 = u.pm * BM + wr * 64 + fr, col0 = u.pn * BM + wc * 32 + 8 * fq;
        const bool rope = (u.pn >= 6 && u.pn < 10);
        const float* dtab = (u.pn >= 8) ? dk : dq;
        const int hb = (u.pn & 1) * 2;
        if (rope) {
#pragma unroll
            for (int ai = 0; ai < 2; ++ai) {
                f32x4 c4[4], s4[4]; float sc[4][2];
#pragma unroll
                for (int m = 0; m < 4; ++m) { const int row = row0 + ai * HALF + m * 16, t = row & 4095, p = t & 127;
                    c4[m] = *(const f32x4*)(cs + t * 64 + 16 * wc + 4 * fq); s4[m] = *(const f32x4*)(sn + t * 64 + 16 * wc + 4 * fq);
                    sc[m][0] = dtab[hb * 128 + p]; sc[m][1] = dtab[(hb + 1) * 128 + p]; }
                __builtin_amdgcn_sched_barrier(0);
#pragma unroll
                for (int m = 0; m < 4; ++m) { bf16_t* rowp = O + (size_t)(row0 + ai * HALF + m * 16) * 3072 + col0;
#pragma unroll
                    for (int bj = 0; bj < 2; ++bj) {
                        const float s_ = sc[m][bj]; const f32x4 cc = c4[m], ss = s4[m];
                        const f32x4 v0 = acc[ai][bj][m][0], v1 = acc[ai][bj][m][1];
                        u32x4 w;
                        w.x = cvt_pk_bf16((v0[0] * cc[0] - v0[1] * ss[0]) * s_, (v0[0] * ss[0] + v0[1] * cc[0]) * s_);
                        w.y = cvt_pk_bf16((v0[2] * cc[1] - v0[3] * ss[1]) * s_, (v0[2] * ss[1] + v0[3] * cc[1]) * s_);
                        w.z = cvt_pk_bf16((v1[0] * cc[2] - v1[1] * ss[2]) * s_, (v1[0] * ss[2] + v1[1] * cc[2]) * s_);
                        w.w = cvt_pk_bf16((v1[2] * cc[3] - v1[3] * ss[3]) * s_, (v1[2] * ss[3] + v1[3] * cc[3]) * s_);
                        *(u32x4*)(rowp + bj * HALF) = w;
                        if (u.pn >= 8) {
                            const int tokrow = row0 + ai * HALF + m * 16, odd = fr & 1;
                            bf16_t* kt = KT + (size_t)((hb + bj) * 128 + wc * 32 + 8 * fq + odd) * ldk + (tokrow - odd);
#pragma unroll
                            for (int q = 0; q < 4; ++q) { const unsigned mine = w[q], other = (unsigned)__shfl_xor((int)mine, 1);
                                const unsigned pr = odd ? ((other >> 16) | (mine & 0xffff0000u)) : ((mine & 0xffffu) | (other << 16));
                                *(unsigned*)(kt + (size_t)(2 * q) * ldk) = pr; }
                        }
                    } }
                __builtin_amdgcn_sched_barrier(0);
            }
        } else if (u.pn >= 12) {
            const int odd = fr & 1;
#pragma unroll
            for (int ai = 0; ai < 2; ++ai)
#pragma unroll
                for (int m = 0; m < 4; ++m) { const int tokrow = row0 + ai * HALF + m * 16;
#pragma unroll
                    for (int bj = 0; bj < 2; ++bj) {
                        const f32x4 v0 = acc[ai][bj][m][0], v1 = acc[ai][bj][m][1];
                        u32x4 w; w.x = cvt_pk_bf16(v0[0], v0[1]); w.y = cvt_pk_bf16(v0[2], v0[3]); w.z = cvt_pk_bf16(v1[0], v1[1]); w.w = cvt_pk_bf16(v1[2], v1[3]);
                        bf16_t* vt = KT + (size_t)(512 + (u.pn - 12) * BM + bj * HALF + wc * 32 + 8 * fq + odd) * ldk + (tokrow - odd);
#pragma unroll
                        for (int q = 0; q < 4; ++q) { const unsigned mine = w[q], other = (unsigned)__shfl_xor((int)mine, 1);
                            const unsigned pr = odd ? ((other >> 16) | (mine & 0xffff0000u)) : ((mine & 0xffffu) | (other << 16));
                            *(unsigned*)(vt + (size_t)(2 * q) * ldk) = pr; }
                    } }
        } else if (u.pn >= 2 && u.pn < 6) {
            const int c0 = (u.pn - 2) * 128 + wc * 16 + 4 * fq;
#pragma unroll
            for (int ai = 0; ai < 2; ++ai)
#pragma unroll
                for (int m = 0; m < 4; ++m) { bf16_t* rowp = O + (size_t)(row0 + ai * HALF + m * 16) * 3072 + 512 + c0;
#pragma unroll
                    for (int bj = 0; bj < 2; ++bj) {
                        const f32x4 v0 = acc[ai][bj][m][0], v1 = acc[ai][bj][m][1];
                        u32x2 w; w.x = cvt_pk_bf16(v0[0] * v0[1], v0[2] * v0[3]); w.y = cvt_pk_bf16(v1[0] * v1[1], v1[2] * v1[3]);
                        *(u32x2*)(rowp + 64 * bj) = w;
                    } }
        } else {
#pragma unroll
            for (int ai = 0; ai < 2; ++ai)
#pragma unroll
                for (int m = 0; m < 4; ++m) { bf16_t* rowp = O + (size_t)(row0 + ai * HALF + m * 16) * 3072 + col0;
#pragma unroll
                    for (int bj = 0; bj < 2; ++bj) {
                        const f32x4 v0 = acc[ai][bj][m][0], v1 = acc[ai][bj][m][1];
                        u32x4 w; w.x = cvt_pk_bf16(v0[0], v0[1]); w.y = cvt_pk_bf16(v0[2], v0[3]); w.z = cvt_pk_bf16(v1[0], v1[1]); w.w = cvt_pk_bf16(v1[2], v1[3]);
                        *(u32x4*)(rowp + bj * HALF) = w;
                    } }
        }
    }
};
struct EpiKVT {
    static constexpr bool PERM = true, AFTER_DRAIN = false;
    bf16_t* O; const float* csT; const float* snT; const float* dk; int ldo;
    __device__ __forceinline__ void operator()(const f32x4 (&acc)[2][2][4][2], const Unit& u, int wr, int wc, int fr, int fq) const {
        const int col0 = u.pn * BM + wc * 32 + 8 * fq;
        if (u.pm < 2) {
#pragma unroll
            for (int bj = 0; bj < 2; ++bj) {
                const int tok = col0 + bj * HALF, t = tok & 4095;
                f32x4 c4[2][2], s4[2][2], d4[2][2];
#pragma unroll
                for (int mm = 0; mm < 2; ++mm)
#pragma unroll
                    for (int n = 0; n < 2; ++n) { const int i = 32 * wr + 16 * mm + fr;
                        c4[mm][n] = *(const f32x4*)(csT + i * (4096 + 32) + t + 4 * n); s4[mm][n] = *(const f32x4*)(snT + i * (4096 + 32) + t + 4 * n);
                        d4[mm][n] = *(const f32x4*)(dk + (2 * u.pm + mm) * 128 + (t & 127) + 4 * n); }
                __builtin_amdgcn_sched_barrier(0);
#pragma unroll
                for (int ai = 0; ai < 2; ++ai)
#pragma unroll
                    for (int mm = 0; mm < 2; ++mm) {
                        const int i = 32 * wr + 16 * mm + fr;
                        bf16_t* r1 = O + (size_t)((2 * u.pm + ai) * 128 + 2 * i) * ldo; bf16_t* r2 = r1 + ldo;
                        u32x4 w1, w2;
#pragma unroll
                        for (int n = 0; n < 2; ++n) {
                            const f32x4 cc = c4[mm][n], ss = s4[mm][n], dd = d4[ai][n];
                            const f32x4 x1 = acc[ai][bj][mm][n], x2 = acc[ai][bj][mm + 2][n];
                            const f32x4 o1 = (x1 * cc - x2 * ss) * dd, o2 = (x1 * ss + x2 * cc) * dd;
                            if (n == 0) { w1.x = cvt_pk_bf16(o1[0], o1[1]); w1.y = cvt_pk_bf16(o1[2], o1[3]); w2.x = cvt_pk_bf16(o2[0], o2[1]); w2.y = cvt_pk_bf16(o2[2], o2[3]); }
                            else        { w1.z = cvt_pk_bf16(o1[0], o1[1]); w1.w = cvt_pk_bf16(o1[2], o1[3]); w2.z = cvt_pk_bf16(o2[0], o2[1]); w2.w = cvt_pk_bf16(o2[2], o2[3]); }
                        }
                        *(u32x4*)(r1 + tok) = w1; *(u32x4*)(r2 + tok) = w2;
                    }
                __builtin_amdgcn_sched_barrier(0);
            }
        } else {
#pragma unroll
            for (int ai = 0; ai < 2; ++ai)
#pragma unroll
                for (int m = 0; m < 4; ++m) {
                    bf16_t* rowp = O + (size_t)(u.pm * BM + ai * HALF + wr * 64 + m * 16 + fr) * ldo + col0;
#pragma unroll
                    for (int bj = 0; bj < 2; ++bj) {
                        const f32x4 v0 = acc[ai][bj][m][0], v1 = acc[ai][bj][m][1];
                        u32x4 w; w.x = cvt_pk_bf16(v0[0], v0[1]); w.y = cvt_pk_bf16(v0[2], v0[3]); w.z = cvt_pk_bf16(v1[0], v1[1]); w.w = cvt_pk_bf16(v1[2], v1[3]);
                        *(u32x4*)(rowp + bj * HALF) = w;
                    }
                }
        }
    }
};
struct EpiVT {
    static constexpr bool PERM = true, AFTER_DRAIN = false;
    bf16_t* O; int ldo;
    __device__ __forceinline__ void operator()(const f32x4 (&acc)[2][2][4][2], const Unit& u, int wr, int wc, int fr, int fq) const {
        const int col0 = u.pn * BM + wc * 32 + 8 * fq;
#pragma unroll
        for (int ai = 0; ai < 2; ++ai)
#pragma unroll
            for (int m = 0; m < 4; ++m) {
                bf16_t* rowp = O + (size_t)(u.pm * BM + ai * HALF + wr * 64 + m * 16 + fr) * ldo + col0;
#pragma unroll
                for (int bj = 0; bj < 2; ++bj) {
                    const f32x4 v0 = acc[ai][bj][m][0], v1 = acc[ai][bj][m][1];
                    u32x4 w; w.x = cvt_pk_bf16(v0[0], v0[1]); w.y = cvt_pk_bf16(v0[2], v0[3]); w.z = cvt_pk_bf16(v1[0], v1[1]); w.w = cvt_pk_bf16(v1[2], v1[3]);
                    *(u32x4*)(rowp + bj * HALF) = w;
                }
            }
    }
};
struct EpiRes {
    static constexpr bool PERM = false, AFTER_DRAIN = false;
    const float* base; float* out; const float* gate;
    __device__ __forceinline__ void operator()(const f32x4 (&acc)[2][2][4][2], const Unit& u, int wr, int wc, int fr, int fq) const {
        const int b = u.pm >> 4, col0 = u.pn * BM + wc * 32 + 4 * fq, row0 = u.pm * BM + wr * 64 + fr;
        f32x4 g[2][2];
#pragma unroll
        for (int bj = 0; bj < 2; ++bj)
#pragma unroll
            for (int n = 0; n < 2; ++n) g[bj][n] = *(const f32x4*)(gate + b * 6144 + col0 + bj * HALF + n * 16);
#pragma unroll
        for (int ai = 0; ai < 2; ++ai) {
            f32x4 bs[4][2][2];
#pragma unroll
            for (int m = 0; m < 4; ++m) { const size_t off = (size_t)(row0 + ai * HALF + m * 16) * 1024 + col0;
#pragma unroll
                for (int bj = 0; bj < 2; ++bj)
#pragma unroll
                    for (int n = 0; n < 2; ++n) bs[m][bj][n] = *(const f32x4*)(base + off + bj * HALF + n * 16); }
            __builtin_amdgcn_sched_barrier(0);
#pragma unroll
            for (int m = 0; m < 4; ++m) { const size_t off = (size_t)(row0 + ai * HALF + m * 16) * 1024 + col0;
#pragma unroll
                for (int bj = 0; bj < 2; ++bj)
#pragma unroll
                    for (int n = 0; n < 2; ++n) *(f32x4*)(out + off + bj * HALF + n * 16) = bs[m][bj][n] + g[bj][n] * acc[ai][bj][m][n]; }
            __builtin_amdgcn_sched_barrier(0);
        }
    }
};
struct EpiRelu2 {
    static constexpr bool PERM = true, AFTER_DRAIN = false;
    bf16_t* O; int ldc;
    __device__ __forceinline__ void operator()(const f32x4 (&acc)[2][2][4][2], const Unit& u, int wr, int wc, int fr, int fq) const {
        const int row0 = u.pm * BM + wr * 64 + fr, col0 = u.pn * BM + wc * 32 + 8 * fq;
#pragma unroll
        for (int ai = 0; ai < 2; ++ai)
#pragma unroll
            for (int m = 0; m < 4; ++m) {
                bf16_t* rowp = O + (size_t)(row0 + ai * HALF + m * 16) * ldc + col0;
#pragma unroll
                for (int bj = 0; bj < 2; ++bj) {
                    f32x4 v0 = acc[ai][bj][m][0], v1 = acc[ai][bj][m][1];
                    v0 = __builtin_elementwise_max(v0, (f32x4){0.f, 0.f, 0.f, 0.f}); v1 = __builtin_elementwise_max(v1, (f32x4){0.f, 0.f, 0.f, 0.f});
                    v0 = v0 * v0; v1 = v1 * v1;
                    u32x4 w; w.x = cvt_pk_bf16(v0[0], v0[1]); w.y = cvt_pk_bf16(v0[2], v0[3]); w.z = cvt_pk_bf16(v1[0], v1[1]); w.w = cvt_pk_bf16(v1[2], v1[3]);
                    __builtin_nontemporal_store(w, (u32x4*)(rowp + bj * HALF));
                }
            }
    }
};
template <class Epi, class Sched, bool ALIGN_EPI = false, bool SP2 = false>
__device__ __forceinline__ void gemm_phase(PG8_LAS unsigned char* lds, const Gemm g, const Sched& S, const Epi& E) {
    int tid = threadIdx.x; asm volatile("" : "+v"(tid));
    const int wid = __builtin_amdgcn_readfirstlane(tid >> 6), lane = tid & 63, wr = wid >> 2, wc = wid & 3, fr = lane & 15, fq = lane >> 4;
    const int K = g.K, nt = K / BK;
    unsigned voffA[2], voffB[2];
#pragma unroll
    for (int i = 0; i < 2; ++i) { int R, C; stage_rc(tid * 16 + i * 8192, R, C); const int Rb = Epi::PERM ? ((R & ~31) + perm32(R & 31)) : R;
        voffA[i] = (unsigned)(R * K + C) * 2u; voffB[i] = (unsigned)(Rb * K + C) * 2u; }
    const size_t kstep = (size_t)(BK * 2);
    const size_t hstep = (size_t)HALF * K * 2;
    const size_t tstep = 2 * hstep;
    const unsigned ldsw = (unsigned)wid * 1024u;
    const int aoff = lds_byte(wr * 64 + fr, fq * 8), boff = lds_byte(wc * 32 + fr, fq * 8);
#define PG8_SA(b, h) (((b) * 2 + (h)) * HTB)
#define PG8_SB(b, h) ((4 + (b) * 2 + (h)) * HTB)
#define PG8_STAGE(bufoff, gbase, voff) do { _Pragma("unroll") for (int _i = 0; _i < 2; ++_i) \
        __builtin_amdgcn_global_load_lds((const unsigned*)((const char*)(gbase) + (voff)[_i]), (PG8_LAS unsigned*)(lds + (bufoff) + ldsw + _i * 8192), 16, 0, 0); } while (0)
#define PG8_LDA(dst, b, h) do { _Pragma("unroll") for (int m = 0; m < 4; ++m) _Pragma("unroll") for (int k = 0; k < 2; ++k) dst[m][k] = *(const PG8_LAS bf16x8*)(lds + PG8_SA(b, h) + aoff + m * 2048 + k * 1024); } while (0)
#define PG8_LDB(dst, b, h) do { _Pragma("unroll") for (int n = 0; n < 2; ++n) _Pragma("unroll") for (int k = 0; k < 2; ++k) dst[n][k] = *(const PG8_LAS bf16x8*)(lds + PG8_SB(b, h) + boff + n * 2048 + k * 1024); } while (0)
#define PG8_MMA(ai, bj, At, Bt) do { __builtin_amdgcn_s_setprio(1); _Pragma("unroll") for (int m = 0; m < 4; ++m) _Pragma("unroll") for (int n = 0; n < 2; ++n) _Pragma("unroll") for (int k = 0; k < 2; ++k) \
        acc[ai][bj][m][n] = __builtin_amdgcn_mfma_f32_16x16x32_bf16(Bt[n][k], At[m][k], acc[ai][bj][m][n], 0, 0, 0); __builtin_amdgcn_s_setprio(0); } while (0)
#define PG8_WAIT_V(n) asm volatile("s_waitcnt vmcnt(" #n ")" ::: "memory")
#define PG8_WAIT_L(n) asm volatile("s_waitcnt lgkmcnt(" #n ")" ::: "memory")
#define PG8_BAR __builtin_amdgcn_s_barrier()
#define PG8_SCHED __builtin_amdgcn_sched_barrier(0)
    Unit cur, nxt; int ui = 0;
    if (!S.next(0, cur)) return;
    f32x4 acc[2][2][4][2];
#pragma unroll
    for (int a = 0; a < 2; ++a)
#pragma unroll
        for (int b = 0; b < 2; ++b)
#pragma unroll
            for (int m = 0; m < 4; ++m)
#pragma unroll
                for (int n = 0; n < 2; ++n) acc[a][b][m][n] = (f32x4){0.f, 0.f, 0.f, 0.f};
    bf16x8 At[4][2], B0[2][2], B1[2][2];
    const char* cA = (const char*)g.A + (size_t)cur.pm * tstep; const char* cB = (const char*)g.Bt + (size_t)cur.pn * tstep;
    S.a_ready(cur);
    if constexpr (SP2) {
        PG8_STAGE(PG8_SB(0, 0), cB, voffB); PG8_STAGE(PG8_SB(0, 1), cB + hstep, voffB); PG8_STAGE(PG8_SA(0, 0), cA, voffA); PG8_STAGE(PG8_SA(0, 1), cA + hstep, voffA);
        if (wr == 1) PG8_BAR;
        PG8_WAIT_V(2); PG8_BAR;
        PG8_STAGE(PG8_SB(1, 0), cB + kstep, voffB); PG8_STAGE(PG8_SA(1, 0), cA + kstep, voffA); PG8_STAGE(PG8_SB(1, 1), cB + hstep + kstep, voffB);
        PG8_WAIT_V(6); PG8_BAR;
    } else {
        PG8_STAGE(PG8_SB(0, 0), cB, voffB); PG8_STAGE(PG8_SA(0, 0), cA, voffA); PG8_STAGE(PG8_SB(0, 1), cB + hstep, voffB); PG8_STAGE(PG8_SA(0, 1), cA + hstep, voffA);
        if (wr == 1) PG8_BAR;
        PG8_WAIT_V(4); PG8_BAR;
        PG8_STAGE(PG8_SB(1, 0), cB + kstep, voffB); PG8_STAGE(PG8_SA(1, 0), cA + kstep, voffA); PG8_STAGE(PG8_SB(1, 1), cB + hstep + kstep, voffB);
        PG8_WAIT_V(6); PG8_BAR;
    }
    for (;;) {
        const bool has_next = S.next(ui + 1, nxt);
        const char* nA = has_next ? (const char*)g.A + (size_t)nxt.pm * tstep : cA; const char* nB = has_next ? (const char*)g.Bt + (size_t)nxt.pn * tstep : cB;
        for (int t = 0; t < nt; t += 2) {
            const bool last = (t == nt - 2);
            const char* a1 = cA + (size_t)(t + 1) * kstep;
            const char* a2 = last ? nA : cA + (size_t)(t + 2) * kstep; const char* b2 = last ? nB : cB + (size_t)(t + 2) * kstep;
            const char* a3 = a2 + kstep; const char* b3 = b2 + kstep;
            if (last && has_next) S.a_ready(nxt);
            if constexpr (SP2) {
            PG8_LDB(B0, 0, 0); PG8_LDB(B1, 0, 1); PG8_SCHED; PG8_LDA(At, 0, 0); PG8_STAGE(PG8_SA(1, 1), a1 + hstep, voffA);
            PG8_WAIT_V(8); PG8_WAIT_L(0); PG8_BAR; PG8_MMA(0, 0, At, B0); PG8_MMA(0, 1, At, B1); PG8_BAR; PG8_SCHED;
            PG8_LDA(At, 0, 1); PG8_STAGE(PG8_SB(0, 0), b2, voffB); PG8_STAGE(PG8_SB(0, 1), b2 + hstep, voffB); PG8_STAGE(PG8_SA(0, 0), a2, voffA);
            PG8_WAIT_V(8); PG8_WAIT_L(0); PG8_BAR; PG8_MMA(1, 0, At, B0); PG8_MMA(1, 1, At, B1); PG8_BAR; PG8_SCHED;
            PG8_LDB(B0, 1, 0); PG8_LDB(B1, 1, 1); PG8_SCHED; PG8_LDA(At, 1, 0); PG8_STAGE(PG8_SA(0, 1), a2 + hstep, voffA);
            PG8_WAIT_V(8); PG8_WAIT_L(0); PG8_BAR; PG8_MMA(0, 0, At, B0); PG8_MMA(0, 1, At, B1); PG8_BAR; PG8_SCHED;
            PG8_LDA(At, 1, 1); PG8_STAGE(PG8_SB(1, 0), b3, voffB); PG8_STAGE(PG8_SB(1, 1), b3 + hstep, voffB); PG8_STAGE(PG8_SA(1, 0), a3, voffA);
            PG8_WAIT_V(8); PG8_WAIT_L(0); PG8_BAR; PG8_MMA(1, 0, At, B0); PG8_MMA(1, 1, At, B1); PG8_BAR; PG8_SCHED;
            } else {
            PG8_LDB(B0, 0, 0); PG8_SCHED; PG8_LDA(At, 0, 0); PG8_STAGE(PG8_SA(1, 1), a1 + hstep, voffA);
            PG8_WAIT_L(8); PG8_BAR; PG8_WAIT_L(0); PG8_MMA(0, 0, At, B0); PG8_BAR; PG8_SCHED;
            PG8_LDB(B1, 0, 1); PG8_STAGE(PG8_SB(0, 0), b2, voffB);
            PG8_BAR; PG8_WAIT_L(0); PG8_MMA(0, 1, At, B1); PG8_BAR;
            PG8_LDA(At, 0, 1); PG8_STAGE(PG8_SA(0, 0), a2, voffA);
            PG8_BAR; PG8_WAIT_L(0); PG8_MMA(1, 0, At, B0); PG8_BAR; PG8_SCHED;
            PG8_STAGE(PG8_SB(0, 1), b2 + hstep, voffB);
            PG8_WAIT_V(6); PG8_BAR; PG8_MMA(1, 1, At, B1); PG8_BAR;
            PG8_LDB(B0, 1, 0); PG8_SCHED; PG8_LDA(At, 1, 0); PG8_STAGE(PG8_SA(0, 1), a2 + hstep, voffA);
            PG8_WAIT_L(8); PG8_BAR; PG8_WAIT_L(0); PG8_MMA(0, 0, At, B0); PG8_BAR; PG8_SCHED;
            PG8_LDB(B1, 1, 1); PG8_STAGE(PG8_SB(1, 0), b3, voffB);
            PG8_BAR; PG8_WAIT_L(0); PG8_MMA(0, 1, At, B1); PG8_BAR;
            PG8_LDA(At, 1, 1); PG8_STAGE(PG8_SA(1, 0), a3, voffA);
            PG8_BAR; PG8_WAIT_L(0); PG8_MMA(1, 0, At, B0); PG8_BAR; PG8_SCHED;
            PG8_STAGE(PG8_SB(1, 1), b3 + hstep, voffB);
            PG8_WAIT_V(6); PG8_BAR; PG8_MMA(1, 1, At, B1); PG8_BAR;
            }
        }
        if constexpr (ALIGN_EPI) { if (wr == 0) PG8_BAR; }
        if constexpr (!Epi::AFTER_DRAIN) { E(acc, cur, wr, wc, fr, fq); S.done(cur); }
        if (!has_next) break;
#pragma unroll
        for (int a = 0; a < 2; ++a)
#pragma unroll
            for (int b = 0; b < 2; ++b)
#pragma unroll
                for (int m = 0; m < 4; ++m)
#pragma unroll
                    for (int n = 0; n < 2; ++n) acc[a][b][m][n] = (f32x4){0.f, 0.f, 0.f, 0.f};
        cur = nxt; cA = nA; cB = nB; ++ui;
        if constexpr (ALIGN_EPI) { if (wr == 1) PG8_BAR; }
    }
    PG8_WAIT_V(0);
    if constexpr (!ALIGN_EPI) { if (wr == 0) PG8_BAR; }
    PG8_BAR;
    if constexpr (Epi::AFTER_DRAIN) { E.fused(acc, cur, wr, wc, fr, fq, lds, wid, lane); S.done(cur); }
#undef PG8_SA
#undef PG8_SB
#undef PG8_STAGE
#undef PG8_LDA
#undef PG8_LDB
#undef PG8_MMA
#undef PG8_WAIT_V
#undef PG8_WAIT_L
#undef PG8_BAR
#undef PG8_SCHED
}
}
#define LAS __attribute__((address_space(3)))
typedef unsigned short bf16;
typedef unsigned v4u __attribute__((ext_vector_type(4)));
typedef unsigned v2u __attribute__((ext_vector_type(2)));
typedef float f32x4 __attribute__((ext_vector_type(4)));
typedef short bf16x8 __attribute__((ext_vector_type(8)));

constexpr int NWAVES = 8, NTHR = NWAVES * 64;
constexpr int BATCH = 8, T = 4096, D = 1024, DEPTH = 4, M = BATCH * T;
constexpr int NHEAD = 4, HD = 128, NCH = T / 128, FF = 4096, NIN = 3584, NMOD = 6 * D;
constexpr int N1 = 3072, N2 = 1024;
constexpr float EPS = 1e-6f;
constexpr size_t MiB = 1u << 20;
constexpr size_t WS_MOD = 0, CTL_ZERO_BYTES = 1 * MiB;
constexpr size_t WS_BAR = 800 * 1024;
constexpr int KVT_LD = M + 2048 + 64, CST_LD = T + 32;
constexpr size_t WS_COS = 1 * MiB, WS_SIN = 2 * MiB, WS_COST = 3 * MiB, WS_SINT = 4 * MiB + 256 * 1024, WS_DQ = 5 * MiB + 512 * 1024, WS_DK = WS_DQ + 4096;
constexpr size_t WS_W = 6 * MiB;
constexpr size_t W_LAYER = 26 * MiB, W_T1 = 0, W_T2 = 6 * MiB, W_O = 8 * MiB, W_U = 10 * MiB, W_D = 18 * MiB;
constexpr size_t WS_XN = WS_W + DEPTH * W_LAYER;
constexpr size_t WS_P1 = WS_XN + 64 * MiB;
constexpr size_t WS_KVT = WS_P1 + 192 * MiB;
constexpr size_t WS_H = WS_P1;
constexpr size_t WS_ST = WS_KVT + 69 * MiB;
constexpr size_t WS_END = WS_ST + 32 * MiB;
constexpr size_t WS_CH = WS_DQ + 65536, CH_X0 = WS_CH, CH_H0 = WS_CH + 32768, CH_P0 = WS_CH + 65536, CH_Y0 = CH_P0 + 8 * 3584 * 4, CH_U0 = CH_Y0 + 32768;
static_assert(CH_U0 + 8 * 4096 * 4 <= 6 * MiB, "chain buffers");
constexpr int LDS_BYTES = 147456;
#ifndef REP_PRO
#define REP_PRO 1
#endif
#ifndef REP_PRO_T
#define REP_PRO_T 1
#endif
#ifndef REP_NORM
#define REP_NORM 1
#endif
#ifndef REP_GEMM_IN
#define REP_GEMM_IN 1
#endif
#ifndef REP_GEMM_UP
#define REP_GEMM_UP 1
#endif
#ifndef REP_RET1
#define REP_RET1 1
#endif
#ifndef REP_RET2
#define REP_RET2 1
#endif
#ifndef XSYNC
#define XSYNC 0
#endif
#ifndef MK_CG_ONLY
#define MK_CG_ONLY 0
#endif
#ifndef MK_NANFILL
#define MK_NANFILL 0
#endif
#ifndef MK_PER_PHASE
#define MK_PER_PHASE 0
#endif

__device__ __forceinline__ unsigned f2bf(float f) { unsigned u = __builtin_bit_cast(unsigned, f); return (u + 0x7fffu + ((u >> 16) & 1u)) >> 16; }
__device__ __forceinline__ unsigned pk2(float lo, float hi) { return f2bf(lo) | (f2bf(hi) << 16); }
__device__ __forceinline__ float bf2f(unsigned short h) { return __builtin_bit_cast(float, (unsigned)h << 16); }
__device__ __forceinline__ float bflo(unsigned w) { return __builtin_bit_cast(float, w << 16); }
__device__ __forceinline__ float bfhi(unsigned w) { return __builtin_bit_cast(float, w & 0xffff0000u); }
#define LDS_WAIT() asm volatile("s_waitcnt lgkmcnt(0)" ::: "memory")
__device__ __forceinline__ float wave_sum(float v) {
#pragma unroll
    for (int o = 1; o < 64; o <<= 1) v += __shfl_xor(v, o);
    return v;
}

__device__ __forceinline__ void tr_load(const float* W, int N, int k0, int n0, LAS float* scr, int lane) {
    float tv[32];
#pragma unroll
    for (int i = 0; i < 32; ++i) tv[i] = W[(size_t)(k0 + 2 * i + (lane >> 5)) * N + n0 + (lane & 31)];
#pragma unroll
    for (int i = 0; i < 32; ++i) scr[(2 * i + (lane >> 5)) * 33 + (lane & 31)] = tv[i];
    LDS_WAIT(); asm volatile("" ::: "memory");
}
__device__ __forceinline__ void win_rows(int c, int& r1, int& r2) {
    const int seg = c >> 9, j = c & 511, head = j >> 7, d = j & 127, i = d & 63, half = d >> 6;
    const int permQ = 2 * i + half, permT = 64 * (i >> 5) + 32 * half + (i & 31);
    r1 = -1; r2 = -1;
    if (seg == 0) r1 = c;
    else if (seg < 3) r1 = 512 + 2 * j + (seg - 1);
    else if (seg == 3) r1 = 1536 + head * 128 + permQ;
    else if (seg == 4) { r1 = 2048 + head * 128 + permQ; (void)permT; }
    else if (seg == 5) r2 = j;
    else r1 = 2560 + j;
}
__device__ __forceinline__ void tr_store_plain(bf16* WT, int K, int k0, int n0, const LAS float* scr, int lane) {
    const int c = lane & 7;
#pragma unroll
    for (int j = 0; j < 4; ++j) { const int n = (lane >> 3) + 8 * j; const LAS float* s = scr + (8 * c) * 33 + n;
        v4u o; o.x = pk2(s[0 * 33], s[1 * 33]); o.y = pk2(s[2 * 33], s[3 * 33]); o.z = pk2(s[4 * 33], s[5 * 33]); o.w = pk2(s[6 * 33], s[7 * 33]);
        *(v4u*)(WT + (size_t)(n0 + n) * K + k0 + 8 * c) = o; }
}
__device__ __forceinline__ void tr_store_win(bf16* Wt1, bf16* Wt2, int k0, int n0, const LAS float* scr, int lane) {
    const int c = lane & 7;
#pragma unroll
    for (int j = 0; j < 4; ++j) { const int n = (lane >> 3) + 8 * j; const LAS float* s = scr + (8 * c) * 33 + n;
        v4u o; o.x = pk2(s[0 * 33], s[1 * 33]); o.y = pk2(s[2 * 33], s[3 * 33]); o.z = pk2(s[4 * 33], s[5 * 33]); o.w = pk2(s[6 * 33], s[7 * 33]);
        int r1, r2; win_rows(n0 + n, r1, r2);
        if (r1 >= 0) *(v4u*)(Wt1 + (size_t)r1 * D + k0 + 8 * c) = o;
        if (r2 >= 0) *(v4u*)(Wt2 + (size_t)r2 * D + k0 + 8 * c) = o; }
}

struct Args { const float* in[13]; float* out; unsigned char* ws; int ph_lo, ph_hi; };

__device__ __forceinline__ void prologue(const Args& a, LAS unsigned char* lds, int tid, int lane, int wave, int bid, int G) {
    unsigned char* ws = a.ws;
    const int gw = bid * NWAVES + wave, NGW = G * NWAVES, gt = bid * NTHR + tid, NGT = G * NTHR;
    {
        float* cs = (float*)(ws + WS_COS); float* sn = (float*)(ws + WS_SIN);
        LAS float* invf = (LAS float*)(lds + 131072 + 256);
        if (tid < 64) invf[tid] = (float)pow(10000.0, -(double)(2 * tid) / 128.0);
        __syncthreads();
        for (int e = gt; e < T * 64; e += NGT) {
            const int t = e >> 6, i = e & 63;
            const double ang = (double)((float)t * invf[i]);
            const double q = __builtin_rint(ang * 0.15915494309189535);
            const float r = (float)(ang - q * 6.283185307179586);
            const float c = cosf(r), s = sinf(r);
            cs[e] = c; sn[e] = s;
        }
        if (bid == 0) {
            float* dq = (float*)(ws + WS_DQ); float* dk = (float*)(ws + WS_DK);
            const int h = tid >> 7, p = tid & 127;
            const double lg = log1p(-exp2(-5.0 - (double)h));
            dq[tid] = (float)exp(lg * (double)(p + 1));
            dk[tid] = (float)(exp(-lg * (double)(p + 1)) * 0.08838834764831845);
            if (p == 0) dk[512 + h] = (float)exp(128.0 * lg);
        }
    }
    {
        LAS float* cact = (LAS float*)(lds + 98304);
        const float* c = a.in[1];
        for (int e = tid; e < BATCH * D; e += NTHR) { const float v = c[e]; cact[e] = v / (1.f + __expf(-v)); }
        __syncthreads();
        float* mod = (float*)(ws + WS_MOD); const float* w_ada = a.in[10]; const float* b_ada = a.in[11];
        LAS float* red = (LAS float*)(lds + 131072 + 256);
        const int col = lane & 31, kh = lane >> 5, k0 = wave * 128;
        for (int it = bid; it < DEPTH * (NMOD / 32); it += G) {
            const int cb = it % (NMOD / 32), l = it / (NMOD / 32);
            const float* W = w_ada + (size_t)l * D * NMOD + (size_t)(k0 + kh) * NMOD + cb * 32 + col;
            float acc[8];
#pragma unroll
            for (int b = 0; b < 8; ++b) acc[b] = 0.f;
            for (int j0 = 0; j0 < 64; j0 += 32) {
                float wv[32];
#pragma unroll
                for (int j = 0; j < 32; ++j) wv[j] = W[(size_t)(2 * (j0 + j)) * NMOD];
#pragma unroll
                for (int j = 0; j < 32; ++j)
#pragma unroll
                    for (int b = 0; b < 8; ++b) acc[b] += cact[b * D + k0 + 2 * (j0 + j) + kh] * wv[j];
            }
#pragma unroll
            for (int b = 0; b < 8; ++b) acc[b] += __shfl_xor(acc[b], 32);
            if (kh == 0) {
#pragma unroll
                for (int b = 0; b < 8; ++b) red[(wave * 8 + b) * 32 + col] = acc[b]; }
            __syncthreads();
            if (tid < 256) { const int b = tid >> 5, c = tid & 31; float s_ = 0.f;
#pragma unroll
                for (int w = 0; w < 8; ++w) s_ += red[(w * 8 + b) * 32 + c];
                mod[((size_t)l * 8 + b) * NMOD + cb * 32 + c] = s_ + b_ada[l * NMOD + cb * 32 + c]; }
            __syncthreads();
        }
    }
    for (int rt_ = 0; rt_ < REP_PRO_T; ++rt_) {
        LAS float* scr = (LAS float*)(lds + wave * 8448);
        constexpr int I_IN = 16 * 112, I_O = 16 * 32, I_U = 16 * 128, I_D = 64 * 32, I_L = I_IN + I_O + I_U + I_D;
        for (int it = gw; it < DEPTH * I_L; it += NGW) {
            const int l = it / I_L; int r = it % I_L;
            unsigned char* wl = ws + WS_W + (size_t)l * W_LAYER;
            if (r < I_IN) { const int kb = r / 112, nb = r % 112; tr_load(a.in[3] + (size_t)l * D * NIN, NIN, 64 * kb, 32 * nb, scr, lane);
                tr_store_win((bf16*)(wl + W_T1), (bf16*)(wl + W_T2), 64 * kb, 32 * nb, scr, lane); LDS_WAIT(); asm volatile("" ::: "memory"); continue; } r -= I_IN;
            if (r < I_O) { const int kb = r / 32, nb = r % 32; tr_load(a.in[6] + (size_t)l * D * D, D, 64 * kb, 32 * nb, scr, lane);
                tr_store_plain((bf16*)(wl + W_O), D, 64 * kb, 32 * nb, scr, lane); LDS_WAIT(); asm volatile("" ::: "memory"); continue; } r -= I_O;
            if (r < I_U) { const int kb = r / 128, nb = r % 128; tr_load(a.in[8] + (size_t)l * D * FF, FF, 64 * kb, 32 * nb, scr, lane);
                tr_store_plain((bf16*)(wl + W_U), D, 64 * kb, 32 * nb, scr, lane); LDS_WAIT(); asm volatile("" ::: "memory"); continue; } r -= I_U;
            { const int kb = r / 32, nb = r % 32; tr_load(a.in[9] + (size_t)l * FF * D, D, 64 * kb, 32 * nb, scr, lane);
                tr_store_plain((bf16*)(wl + W_D), FF, 64 * kb, 32 * nb, scr, lane); LDS_WAIT(); asm volatile("" ::: "memory"); }
        }
    }
}

__device__ __forceinline__ void norm_mod_phase(const float* x, const float* x0src, size_t x0stride, float* h0buf, const float* g, const float* sh, const float* sc, bf16* XN, int gw, int NGW, int lane) {
    const int wpb = NGW / BATCH, rpw = T / wpb;
    const int b = gw / wpb, wi = gw - b * wpb;
    f32x4 gm[4], s0[4];
#pragma unroll
    for (int j = 0; j < 4; ++j) { const int col = 4 * lane + 256 * j; gm[j] = *(const f32x4*)(g + col) * (*(const f32x4*)(sc + b * NMOD + col) + 1.f); s0[j] = *(const f32x4*)(sh + b * NMOD + col); }
    for (int k = 0; k < rpw; k += 4) {
        f32x4 v[4][4];
#pragma unroll
        for (int r = 0; r < 4; ++r) { const int t = wi + wpb * (k + r); const bool t0 = t == 0;
            const f32x4* xr = (const f32x4*)(t0 ? x0src + (size_t)b * x0stride : x + ((size_t)b * T + t) * D) + lane;
#pragma unroll
            for (int j = 0; j < 4; ++j) v[r][j] = xr[64 * j]; }
        __builtin_amdgcn_sched_barrier(0);
#pragma unroll
        for (int r = 0; r < 4; ++r) { const int t = wi + wpb * (k + r); const bool t0 = t == 0; const size_t row = (size_t)b * T + t;
            float ss = 0.f;
#pragma unroll
            for (int j = 0; j < 4; ++j) ss += (v[r][j].x * v[r][j].x + v[r][j].y * v[r][j].y) + (v[r][j].z * v[r][j].z + v[r][j].w * v[r][j].w);
            const float rstd = 1.f / sqrtf(wave_sum(ss) * (1.f / D) + EPS);
#pragma unroll
            for (int j = 0; j < 4; ++j) { const int col = 4 * lane + 256 * j;
                const f32x4 h = v[r][j] * rstd * gm[j] + s0[j];
                v2u o; o.x = pk2(h.x, h.y); o.y = pk2(h.z, h.w);
                *(v2u*)(XN + row * D + col) = o;
                if (t0) *(f32x4*)(h0buf + b * D + col) = h; } }
    }
}
__device__ __forceinline__ void final_norm_phase(float* x, const float* x0buf, const float* g, int gw, int NGW, int lane) {
    f32x4 gg[4];
#pragma unroll
    for (int j = 0; j < 4; ++j) gg[j] = *(const f32x4*)(g + 4 * lane + 256 * j);
    for (int row0 = gw; row0 < M; row0 += 4 * NGW) {
        f32x4 v[4][4];
#pragma unroll
        for (int r = 0; r < 4; ++r) { const int row = row0 + r * NGW; const bool t0 = (row & 4095) == 0;
            const f32x4* xs = t0 ? (const f32x4*)(x0buf + (size_t)(row >> 12) * D) + lane : (const f32x4*)(x + (size_t)row * D) + lane;
#pragma unroll
            for (int j = 0; j < 4; ++j) v[r][j] = xs[64 * j]; }
        __builtin_amdgcn_sched_barrier(0);
#pragma unroll
        for (int r = 0; r < 4; ++r) { const int row = row0 + r * NGW; f32x4* xr = (f32x4*)(x + (size_t)row * D) + lane;
            float ss = 0.f;
#pragma unroll
            for (int j = 0; j < 4; ++j) ss += (v[r][j].x * v[r][j].x + v[r][j].y * v[r][j].y) + (v[r][j].z * v[r][j].z + v[r][j].w * v[r][j].w);
            const float rstd = 1.f / sqrtf(wave_sum(ss) * (1.f / D) + EPS);
#pragma unroll
            for (int j = 0; j < 4; ++j) xr[64 * j] = v[r][j] * rstd * gg[j]; }
    }
}
template <int MODE, int COLS>
__device__ __forceinline__ void chain_gemv(LAS unsigned char* lds, const float* W, int K, int N, const float* in, float* out, const float* base, size_t bstride, const float* gate, int bid, int G, int tid, int lane, int wave) {
    constexpr int KS = 64 / COLS;
    const int nitem = N / COLS;
    if (bid >= nitem) return;
    const int Kw = K >> 3, k0 = wave * Kw, col = lane & (COLS - 1), ksub = lane / COLS;
    LAS float* lin = (LAS float*)lds + wave * (8 * Kw);
    LAS float* red = (LAS float*)(lds + 131072 + 256);
    for (int b = 0; b < 8; ++b) for (int kk = lane; kk < Kw; kk += 64) lin[b * Kw + kk] = in[(size_t)b * K + k0 + kk];
    LDS_WAIT(); asm volatile("" ::: "memory");
    const bool swz = (G == 256 && nitem == 256);
    for (int it = bid; it < nitem; it += G) {
        const int item = swz ? (it & 7) * 32 + (it >> 3) : it;
        const float* Wp = W + (size_t)(k0 + ksub) * N + item * COLS + col;
        float acc[8];
#pragma unroll
        for (int b = 0; b < 8; ++b) acc[b] = 0.f;
        const int nj = Kw / KS;
        constexpr int JB = (COLS == 16) ? 32 : 8;
        for (int j0 = 0; j0 < nj; j0 += JB) {
            float wv[JB];
#pragma unroll
            for (int j = 0; j < JB; ++j) wv[j] = Wp[(size_t)(KS * (j0 + j)) * N];
#pragma unroll
            for (int j = 0; j < JB; ++j)
#pragma unroll
                for (int b = 0; b < 8; ++b) acc[b] += lin[b * Kw + KS * (j0 + j) + ksub] * wv[j];
        }
#pragma unroll
        for (int b = 0; b < 8; ++b) {
#pragma unroll
            for (int o = COLS; o < 64; o <<= 1) acc[b] += __shfl_xor(acc[b], o); }
        if (ksub == 0) {
#pragma unroll
            for (int b = 0; b < 8; ++b) red[(wave * 8 + b) * COLS + col] = acc[b]; }
        __syncthreads();
        if (tid < 8 * COLS) { const int b = tid / COLS, c = tid & (COLS - 1), n = item * COLS + c; float s = 0.f;
#pragma unroll
            for (int w = 0; w < 8; ++w) s += red[(w * 8 + b) * COLS + c];
            if (MODE == 0) out[(size_t)b * N + n] = s;
            else if (MODE == 2) { const float r = fmaxf(s, 0.f); out[(size_t)b * N + n] = r * r; }
            else out[(size_t)b * N + n] = base[(size_t)b * bstride + n] + gate[b * NMOD + n] * s; }
        __syncthreads();
    }
}
__device__ __forceinline__ void chain_mixer(const float* proj0, const float* cw, const float* retg, float* y0, int wave, int lane) {
    const float* p = proj0 + wave * NIN; float* y = y0 + wave * D;
    float pv[56], cwv[8], rg[8];
#pragma unroll
    for (int i = 0; i < 56; ++i) pv[i] = p[lane + 64 * i];
#pragma unroll
    for (int i = 0; i < 8; ++i) { cwv[i] = cw[1024 + lane + 64 * i]; rg[i] = retg[lane + 64 * i]; }
    __builtin_amdgcn_sched_barrier(0);
#pragma unroll
    for (int i = 0; i < 8; ++i) y[lane + 64 * i] = pv[i] * (cwv[i] * (pv[8 + i] * pv[16 + i]));
#pragma unroll
    for (int h = 0; h < NHEAD; ++h) {
        const float q0 = pv[24 + 2 * h], q1 = pv[25 + 2 * h], k0 = pv[32 + 2 * h], k1 = pv[33 + 2 * h], v0 = pv[40 + 2 * h], v1 = pv[41 + 2 * h], g0 = pv[48 + 2 * h], g1 = pv[49 + 2 * h];
        const float score = wave_sum(q0 * k0 + q1 * k1) * 0.08838834764831845f;
        const float o0 = score * v0, o1 = score * v1;
        const float mu = wave_sum(o0 + o1) * (1.f / 128.f);
        const float d0 = o0 - mu, d1 = o1 - mu;
        const float rstd = 1.f / sqrtf(wave_sum(d0 * d0 + d1 * d1) * (1.f / 128.f) + EPS);
        y[512 + h * 128 + lane] = (g0 / (1.f + __expf(-g0))) * (d0 * rstd * rg[2 * h]);
        y[512 + h * 128 + lane + 64] = (g1 / (1.f + __expf(-g1))) * (d1 * rstd * rg[2 * h + 1]);
    }
}

#define MFMA16(a, b, c) __builtin_amdgcn_mfma_f32_16x16x32_bf16(a, b, c, 0, 0, 0)
__device__ __forceinline__ void ret_scan_phase(const bf16* KVT, bf16* ST, const float* cdtab, int bid, int G, int wave, int lane) {
    const int fr = lane & 15, fq = lane >> 4;
    for (int unit = bid; unit < 256; unit += G) {
        const int bh = (unit & 7) * 4 + (unit >> 6), es = (unit >> 3) & 7, h = bh & 3, b = bh >> 2;
        const float cd = cdtab[h];
        const bf16* kp0 = KVT + (size_t)(h * 128 + 16 * wave + fr) * KVT_LD + (size_t)b * T + 8 * fq;
        const bf16* kp1 = kp0 + (size_t)64 * KVT_LD;
        const bf16* vp = KVT + (size_t)(512 + h * 128 + 16 * es + fr) * KVT_LD + (size_t)b * T + 8 * fq;
        bf16* sp = ST + (size_t)((b * 4 + h) * NCH) * 16384 + (16 * es + fr) * 128 + 16 * wave + 4 * fq;
        f32x4 acc0 = {0.f, 0.f, 0.f, 0.f}, acc1 = {0.f, 0.f, 0.f, 0.f};
        bf16x8 x0[2][4], x1[2][4], ys[2][4];
#pragma unroll
        for (int s = 0; s < 2; ++s)
#pragma unroll
            for (int kk = 0; kk < 4; ++kk) { x0[s][kk] = *(const bf16x8*)(kp0 + s * 128 + 32 * kk); x1[s][kk] = *(const bf16x8*)(kp1 + s * 128 + 32 * kk); ys[s][kk] = *(const bf16x8*)(vp + s * 128 + 32 * kk); }
        for (int n = 0; n < NCH; n += 2) {
#pragma unroll
            for (int s = 0; s < 2; ++s) {
                { v2u o; o.x = pk2(acc0[0], acc0[1]); o.y = pk2(acc0[2], acc0[3]); *(v2u*)(sp + (size_t)(n + s) * 16384) = o;
                  o.x = pk2(acc1[0], acc1[1]); o.y = pk2(acc1[2], acc1[3]); *(v2u*)(sp + (size_t)(n + s) * 16384 + 64) = o; }
#pragma unroll
                for (int kk = 0; kk < 4; ++kk) { acc0 = MFMA16(x0[s][kk], ys[s][kk], acc0); acc1 = MFMA16(x1[s][kk], ys[s][kk], acc1); }
                acc0 = acc0 * cd; acc1 = acc1 * cd;
                if (n + 2 < NCH) {
#pragma unroll
                    for (int kk = 0; kk < 4; ++kk) { x0[s][kk] = *(const bf16x8*)(kp0 + (n + s + 2) * 128 + 32 * kk); x1[s][kk] = *(const bf16x8*)(kp1 + (n + s + 2) * 128 + 32 * kk); ys[s][kk] = *(const bf16x8*)(vp + (n + s + 2) * 128 + 32 * kk); }
                }
            }
        }
    }
}
__device__ __forceinline__ void conv_phase(const bf16* P1, const float* cw, bf16* Y, int gw, int NGW, int lane) {
    float w0[8], w1[8], w2[8];
#pragma unroll
    for (int k = 0; k < 8; ++k) { w0[k] = cw[8 * lane + k]; w1[k] = cw[512 + 8 * lane + k]; w2[k] = cw[1024 + 8 * lane + k]; }
    for (int run = gw; run < M / 16; run += NGW) {
        const int tok0 = run * 16, t0 = tok0 & 4095;
        float z1[8], z2[8];
#pragma unroll
        for (int k = 0; k < 8; ++k) { z1[k] = 0.f; z2[k] = 0.f; }
        if (t0 != 0) {
            const bf16* r2 = P1 + (size_t)(tok0 - 2) * N1 + 8 * lane; const bf16* r1 = r2 + N1;
            const v4u c2 = *(const v4u*)(r2 + 512), c1 = *(const v4u*)(r1 + 512);
#pragma unroll
            for (int k = 0; k < 4; ++k) { z2[2 * k] = bflo(c2[k]); z2[2 * k + 1] = bfhi(c2[k]); z1[2 * k] = bflo(c1[k]); z1[2 * k + 1] = bfhi(c1[k]); }
        }
        for (int i0 = 0; i0 < 16; i0 += 8) {
            v4u bbv[8], ccv[8];
#pragma unroll
            for (int i = 0; i < 8; ++i) { const bf16* r = P1 + (size_t)(tok0 + i0 + i) * N1 + 8 * lane; bbv[i] = *(const v4u*)r; ccv[i] = *(const v4u*)(r + 512); }
            __builtin_amdgcn_sched_barrier(0);
#pragma unroll
            for (int i = 0; i < 8; ++i) {
                const v4u bb = bbv[i], cc = ccv[i];
                float z0[8], y[8];
#pragma unroll
                for (int k = 0; k < 4; ++k) { z0[2 * k] = bflo(cc[k]); z0[2 * k + 1] = bfhi(cc[k]); }
#pragma unroll
                for (int k = 0; k < 4; ++k) {
                    y[2 * k] = bflo(bb[k]) * (w0[2 * k] * z2[2 * k] + w1[2 * k] * z1[2 * k] + w2[2 * k] * z0[2 * k]);
                    y[2 * k + 1] = bfhi(bb[k]) * (w0[2 * k + 1] * z2[2 * k + 1] + w1[2 * k + 1] * z1[2 * k + 1] + w2[2 * k + 1] * z0[2 * k + 1]);
                }
                v4u o; o.x = pk2(y[0], y[1]); o.y = pk2(y[2], y[3]); o.z = pk2(y[4], y[5]); o.w = pk2(y[6], y[7]);
                *(v4u*)(Y + (size_t)(tok0 + i0 + i) * D + 8 * lane) = o;
#pragma unroll
                for (int k = 0; k < 8; ++k) { z2[k] = z1[k]; z1[k] = z0[k]; }
            }
            __builtin_amdgcn_sched_barrier(0);
        }
    }
}
__device__ __forceinline__ void ret_out_phase(const bf16* P1, const bf16* KVT, const bf16* ST, const float* retg, bf16* Y, LAS unsigned char* lds, int bid, int G, int tid, int wave, int lane) {
    constexpr int NU = BATCH * NHEAD * NCH, PITCH = 272, TILE = 128 * PITCH;
    const int fr = lane & 15, fq = lane >> 4;
    LAS unsigned char* lS = lds; LAS unsigned char* lK = lds + TILE; LAS unsigned char* lV = lds + 2 * TILE;
    v4u pS[4], pK[4], pV[4]; bf16x8 qn[4]; v2u gn[8];
#define R2_ISSUE(unit_, w_) do { const int n_ = (unit_) & 31, h_ = ((unit_) >> 5) & 3, b_ = (unit_) >> 7; const size_t tok0_ = (size_t)b_ * T + 128 * n_; \
        _Pragma("unroll") for (int i = 0; i < 4; ++i) { const int idx = tid + NTHR * i, r = idx >> 4, c = idx & 15; \
            pS[i] = *(const v4u*)(ST + (size_t)(unit_) * 16384 + r * 128 + c * 8); \
            pK[i] = *(const v4u*)(P1 + (tok0_ + r) * N1 + 2048 + h_ * 128 + c * 8); \
            pV[i] = *(const v4u*)(KVT + (size_t)(512 + h_ * 128 + r) * KVT_LD + tok0_ + c * 8); } \
        const bf16* qr_ = P1 + (tok0_ + 16 * (w_) + fr) * N1 + h_ * 128; \
        _Pragma("unroll") for (int kd = 0; kd < 4; ++kd) qn[kd] = *(const bf16x8*)(qr_ + 1536 + 8 * fq + 32 * kd); \
        _Pragma("unroll") for (int te = 0; te < 8; ++te) gn[te] = *(const v2u*)(qr_ + 2560 + 4 * fq + 16 * te); } while (0)
#define R2_WRITE() do { _Pragma("unroll") for (int i = 0; i < 4; ++i) { const int idx = tid + NTHR * i, r = idx >> 4, c = idx & 15; \
            *(LAS v4u*)(lS + r * PITCH + c * 16) = pS[i]; *(LAS v4u*)(lK + r * PITCH + c * 16) = pK[i]; *(LAS v4u*)(lV + r * PITCH + c * 16) = pV[i]; } } while (0)
    int uc = 0, unit = bid;
    if (unit < NU) { R2_ISSUE(unit, wave); R2_WRITE(); }
    __syncthreads();
    for (; unit < NU; unit += G, ++uc) {
        const int w = (uc & 1) ? 7 - wave : wave;
        const int n = unit & 31, h = (unit >> 5) & 3, b = unit >> 7;
        const size_t tok0 = (size_t)b * T + 128 * n;
        bf16x8 qf[4]; v2u gq[8];
#pragma unroll
        for (int kd = 0; kd < 4; ++kd) qf[kd] = qn[kd];
#pragma unroll
        for (int te = 0; te < 8; ++te) gq[te] = gn[te];
        const int nxt = unit + G; const bool has = nxt < NU;
        if (has) { const int wn = ((uc + 1) & 1) ? 7 - wave : wave; R2_ISSUE(nxt, wn); }
        __builtin_amdgcn_sched_barrier(0);
        f32x4 o[8];
#pragma unroll
        for (int te = 0; te < 8; ++te) o[te] = (f32x4){0.f, 0.f, 0.f, 0.f};
#pragma unroll
        for (int te = 0; te < 8; ++te)
#pragma unroll
            for (int kd = 0; kd < 4; ++kd) o[te] = MFMA16(*(const LAS bf16x8*)(lS + (16 * te + fr) * PITCH + kd * 64 + fq * 16), qf[kd], o[te]);
        const int nb = (w >> 1) + 1;
        for (int kk = 0; kk < nb; ++kk) {
            f32x4 sc[2];
#pragma unroll
            for (int t01 = 0; t01 < 2; ++t01) { sc[t01] = (f32x4){0.f, 0.f, 0.f, 0.f};
                const LAS unsigned char* kr = lK + (32 * kk + 8 * (fr >> 2) + (fr & 3) + 4 * t01) * PITCH + fq * 16;
#pragma unroll
                for (int kd = 0; kd < 4; ++kd) sc[t01] = MFMA16(*(const LAS bf16x8*)(kr + kd * 64), qf[kd], sc[t01]); }
            if (kk == nb - 1) { const int i = 16 * w + fr;
#pragma unroll
                for (int t01 = 0; t01 < 2; ++t01)
#pragma unroll
                    for (int r = 0; r < 4; ++r) { const int j = 32 * kk + 8 * fq + 4 * t01 + r; if (j > i) sc[t01][r] = 0.f; } }
            v4u pw; pw.x = pk2(sc[0][0], sc[0][1]); pw.y = pk2(sc[0][2], sc[0][3]); pw.z = pk2(sc[1][0], sc[1][1]); pw.w = pk2(sc[1][2], sc[1][3]);
            const bf16x8 pf = __builtin_bit_cast(bf16x8, pw);
#pragma unroll
            for (int te = 0; te < 8; ++te) o[te] = MFMA16(*(const LAS bf16x8*)(lV + (16 * te + fr) * PITCH + kk * 64 + fq * 16), pf, o[te]);
        }
        float s = 0.f;
#pragma unroll
        for (int te = 0; te < 8; ++te) s += (o[te][0] + o[te][1]) + (o[te][2] + o[te][3]);
        s += __shfl_xor(s, 16); s += __shfl_xor(s, 32);
        const float mean = s * (1.f / 128.f); float q = 0.f;
#pragma unroll
        for (int te = 0; te < 8; ++te) { const f32x4 dlt = o[te] - mean; q += (dlt[0] * dlt[0] + dlt[1] * dlt[1]) + (dlt[2] * dlt[2] + dlt[3] * dlt[3]); }
        q += __shfl_xor(q, 16); q += __shfl_xor(q, 32);
        const float rstd = 1.f / sqrtf(q * (1.f / 128.f) + EPS);
        bf16* yrow = Y + (tok0 + 16 * w + fr) * D + 512 + h * 128 + 4 * fq;
        const float* gg = retg + h * 128 + 4 * fq;
#pragma unroll
        for (int te = 0; te < 8; ++te) {
            const v2u gw2 = gq[te]; const f32x4 g4 = *(const f32x4*)(gg + 16 * te);
            float gv[4] = {bflo(gw2.x), bfhi(gw2.x), bflo(gw2.y), bfhi(gw2.y)}; float y[4];
#pragma unroll
            for (int r = 0; r < 4; ++r) { const float sl = gv[r] / (1.f + __expf(-gv[r])); y[r] = (o[te][r] - mean) * rstd * g4[r] * sl; }
            v2u ov; ov.x = pk2(y[0], y[1]); ov.y = pk2(y[2], y[3]);
            *(v2u*)(yrow + 16 * te) = ov;
        }
        __syncthreads();
        if (has) R2_WRITE();
        __syncthreads();
    }
#undef R2_ISSUE
#undef R2_WRITE
}

#define XB_TMO      128
#define XB_XCNT(j)  (256  + 64 * (j))
#define XB_XSUB(j)  (1280 + 64 * (j))
#define XB_XGEN(j)  (2304 + 64 * (j))
#define XB_TOP      3328
#define XB_TOPGEN   3392
#define XCD_BAR_WORDS 3456
#define XB_SPIN_CAP (1u << 18)

__device__ __forceinline__ unsigned xb_ld(unsigned* p)              { return __hip_atomic_load(p, __ATOMIC_RELAXED, __HIP_MEMORY_SCOPE_AGENT); }
__device__ __forceinline__ unsigned xb_add(unsigned* p, unsigned v) { return __hip_atomic_fetch_add(p, v, __ATOMIC_RELAXED, __HIP_MEMORY_SCOPE_AGENT); }
__device__ __forceinline__ unsigned xb_xcc_id() { return (unsigned)__builtin_amdgcn_s_getreg((3 << 11) | 20) & 0xFu; }
#define XB_SPIN(cond, bar) do { unsigned _sp = 0; while (cond) { __builtin_amdgcn_s_sleep(1); \
    if ((++_sp & 255u) == 0u) { if (xb_ld(&(bar)[XB_TMO])) break; if (_sp > XB_SPIN_CAP) { atomicAdd(&(bar)[XB_TMO], 1u); break; } } } } while (0)

struct XcdBarrier {
    unsigned* bar; unsigned x;
    volatile LAS unsigned* st;
};

__device__ __forceinline__ XcdBarrier xcd_barrier_post(unsigned* bar, volatile LAS unsigned* st) {
    XcdBarrier b; b.bar = bar; b.x = xb_xcc_id(); b.st = st;
    if (threadIdx.x == 0) (void)xb_add(&bar[XB_XCNT(b.x)], 1u);
    return b;
}
__device__ __forceinline__ void xcd_barrier_complete(unsigned* bar, unsigned x, unsigned& nloc, unsigned& nx) {
    const unsigned G = gridDim.x * gridDim.y * gridDim.z;
    unsigned sum, cnt, mine, sp = 0u;
    for (;;) {
        sum = 0u; cnt = 0u; mine = 0u;
#pragma unroll
        for (unsigned j = 0; j < 16; ++j) { const unsigned c = xb_ld(&bar[XB_XCNT(j)]); sum += c; cnt += (c > 0u) ? 1u : 0u; mine = (j == x) ? c : mine; }
        if (sum == G) break;
        __builtin_amdgcn_s_sleep(1);
        if ((++sp & 255u) == 0u) { if (xb_ld(&bar[XB_TMO])) break; if (sp > XB_SPIN_CAP) { atomicAdd(&bar[XB_TMO], 1u); break; } }
    }
    nloc = mine > 0u ? mine : 1u; nx = cnt > 0u ? cnt : 1u;
}

__device__ __forceinline__ void xcd_barrier(const XcdBarrier& b) {
    asm volatile("s_waitcnt vmcnt(0)" ::: "memory");
    __syncthreads();
    if (threadIdx.x == 0) {
        unsigned* bar = b.bar;
        __builtin_amdgcn_s_waitcnt(0);
        unsigned nloc = b.st[0], nx = b.st[1];
        if (nloc == 0u) { xcd_barrier_complete(bar, b.x, nloc, nx); b.st[0] = nloc; b.st[1] = nx; }
        const unsigned old = xb_add(&bar[XB_XSUB(b.x)], 1u);
        const unsigned gen = old / nloc;
        if (old + 1u == (gen + 1u) * nloc) {
            __builtin_amdgcn_fence(__ATOMIC_RELEASE, "agent");
            asm volatile("s_waitcnt vmcnt(0)" ::: "memory");
            const unsigned og = xb_add(&bar[XB_TOP], 1u);
            const unsigned tg = og / nx;
            if (og + 1u == (tg + 1u) * nx) xb_add(&bar[XB_TOPGEN], 1u);
            else XB_SPIN(xb_ld(&bar[XB_TOPGEN]) == tg, bar);
            __builtin_amdgcn_fence(__ATOMIC_ACQUIRE, "agent");
            xb_add(&bar[XB_XGEN(b.x)], 1u);
            asm volatile("s_waitcnt vmcnt(0)" ::: "memory");
        } else {
            XB_SPIN(xb_ld(&bar[XB_XGEN(b.x)]) == gen, bar);
            __builtin_amdgcn_fence(__ATOMIC_ACQUIRE, "agent");
            asm volatile("s_waitcnt vmcnt(0)" ::: "memory");
        }
    }
    __syncthreads();
}

__device__ __forceinline__ unsigned long long tab_get(int k, LAS unsigned char* lds) {
    const LAS unsigned* t = (const LAS unsigned*)(lds + 131072) + 2 * k;
    const unsigned lo = __builtin_amdgcn_readfirstlane(t[0]), hi = __builtin_amdgcn_readfirstlane(t[1]);
    return ((unsigned long long)hi << 32) | lo;
}
__global__ void __launch_bounds__(NTHR, 2) fwd_kernel(Args a) {
    extern __shared__ __attribute__((aligned(16))) unsigned char lds_raw[];
    cg::grid_group grid = cg::this_grid();
    LAS unsigned char* lds = (LAS unsigned char*)lds_raw;
    const int lo = a.ph_lo, hi = a.ph_hi; int ph = 0;
    if (threadIdx.x == 0) {
        LAS unsigned long long* t = (LAS unsigned long long*)(lds + 131072);
#pragma unroll
        for (int i = 0; i < 13; ++i) t[i] = (unsigned long long)a.in[i];
        t[13] = (unsigned long long)a.out; t[14] = (unsigned long long)a.ws;
        ((LAS unsigned*)(lds + 131072 + 128))[0] = 0u; ((LAS unsigned*)(lds + 131072 + 128))[1] = 0u;
    }
    if (blockIdx.x == 0) { unsigned* bw = (unsigned*)(a.ws + WS_BAR); for (int i = threadIdx.x; i < XCD_BAR_WORDS; i += NTHR) bw[i] = 0u; }
    __syncthreads();
#define GASP __attribute__((address_space(1)))
#define IN(k) ((const float*)(const GASP float*)tab_get((k), lds))
#define XO() ((float*)(GASP float*)tab_get(13, lds))
#define WS() ((unsigned char*)(GASP unsigned char*)tab_get(14, lds))
#define RUN(k) (lo <= (k) && (k) < hi)
#define BG() int bid = blockIdx.x, G = gridDim.x; asm volatile("" : "+s"(bid), "+s"(G))
#define LT() BG(); const int NGW = G * NWAVES; int tid = threadIdx.x; asm volatile("" : "+v"(tid)); const int lane = tid & 63, wave = __builtin_amdgcn_readfirstlane(tid >> 6), gw = bid * NWAVES + wave; (void)lane; (void)gw; (void)NGW
#define SEAM() do { ++ph; if (lo < ph && ph < hi) { \
    if (ph == 1 || MK_CG_ONLY) { asm volatile("s_waitcnt vmcnt(0) lgkmcnt(0)" ::: "memory"); __syncthreads();   \
        if (threadIdx.x == 0) { __builtin_amdgcn_fence(__ATOMIC_RELEASE, "agent"); asm volatile("s_waitcnt vmcnt(0)" ::: "memory"); }   \
        for (int xs_ = 0; xs_ < 1 + XSYNC; ++xs_) grid.sync(); \
        if (threadIdx.x == 0) { __builtin_amdgcn_fence(__ATOMIC_ACQUIRE, "agent"); asm volatile("s_waitcnt vmcnt(0)" ::: "memory"); } __syncthreads(); \
        if (!MK_CG_ONLY) (void)xcd_barrier_post((unsigned*)(WS() + WS_BAR), (volatile LAS unsigned*)(lds + 131072 + 128)); } \
    else { XcdBarrier xb_; xb_.bar = (unsigned*)(WS() + WS_BAR); xb_.x = xb_xcc_id(); xb_.st = (volatile LAS unsigned*)(lds + 131072 + 128); \
        for (int xs_ = 0; xs_ < 1 + XSYNC; ++xs_) xcd_barrier(xb_); } } } while (0)

#if defined(MK_NANFILL) && MK_NANFILL
    if (RUN(ph)) { LT(); unsigned char* ws = WS(); v4u* p = (v4u*)(ws + WS_COS); const size_t n16 = (WS_END - WS_COS) / 16; const v4u q = {0xffffffffu, 0xffffffffu, 0xffffffffu, 0xffffffffu};
        for (size_t i = (size_t)bid * NTHR + tid; i < n16; i += (size_t)G * NTHR) p[i] = q;
        { v4u* z = (v4u*)(ws + WS_MOD); const v4u zz = {0u, 0u, 0u, 0u}; for (size_t i = (size_t)bid * NTHR + tid; i < CTL_ZERO_BYTES / 16; i += (size_t)G * NTHR) z[i] = zz; }
        v4u* o = (v4u*)XO(); for (size_t i = (size_t)bid * NTHR + tid; i < (size_t)M * D / 4; i += (size_t)G * NTHR) o[i] = q; }
    SEAM();
#endif
    if (RUN(ph)) for (int rep_ = 0; rep_ < REP_PRO; ++rep_) { LT(); prologue(a, lds, tid, lane, wave, bid, G); }
    SEAM();
    for (int l = 0; l < DEPTH; ++l) {
        if (RUN(ph)) for (int rep_ = 0; rep_ < REP_NORM; ++rep_) { LT(); unsigned char* ws = WS(); const float* modl = (const float*)(ws + WS_MOD) + (size_t)l * 8 * NMOD;
            norm_mod_phase(l == 0 ? IN(0) : (const float*)XO(), l == 0 ? IN(0) : (const float*)(ws + CH_X0), l == 0 ? (size_t)T * D : (size_t)D, (float*)(ws + CH_H0), IN(2) + l * D, modl, modl + D, (bf16*)(ws + WS_XN), gw, NGW, lane); }
        SEAM();
        if (RUN(ph)) for (int rep_ = 0; rep_ < REP_GEMM_IN; ++rep_) {
            { BG(); unsigned char* ws = WS(); unsigned char* wl = ws + WS_W + (size_t)l * W_LAYER;
              static_assert(W_T2 == W_T1 + (size_t)N1 * D * 2, "the v weight rows continue Wt1");
              pg8::Gemm g{(const bf16*)(ws + WS_XN), (const bf16*)(wl + W_T1), M, NIN, D}; pg8::StaticOrder S; S.init(M, NIN, G, bid);
              pg8::EpiInProj E{(bf16*)(ws + WS_P1), (const float*)(ws + WS_COS), (const float*)(ws + WS_SIN), (const float*)(ws + WS_DQ), (const float*)(ws + WS_DK), (bf16*)(ws + WS_KVT), KVT_LD};
              pg8::gemm_phase<pg8::EpiInProj, pg8::StaticOrder, true, true>(lds, g, S, E); }
            { LT(); unsigned char* ws = WS(); chain_gemv<0, 16>(lds, IN(3) + (size_t)l * D * NIN, D, NIN, (const float*)(ws + CH_H0), (float*)(ws + CH_P0), nullptr, 0, nullptr, bid, G, tid, lane, wave); }
        }
        SEAM();
        if (RUN(ph)) for (int rep_ = 0; rep_ < REP_RET1; ++rep_) { LT(); unsigned char* ws = WS();
            if (wave < 4) ret_scan_phase((const bf16*)(ws + WS_KVT), (bf16*)(ws + WS_ST), (const float*)(ws + WS_DK) + 512, bid, G, wave, lane);
            else conv_phase((const bf16*)(ws + WS_P1), IN(4) + l * 3 * 512, (bf16*)(ws + WS_XN), bid * 4 + (wave - 4), G * 4, lane);
            if (bid == G - 1) chain_mixer((const float*)(ws + CH_P0), IN(4) + l * 3 * 512, IN(5) + l * 512, (float*)(ws + CH_Y0), wave, lane); }
        SEAM();
        if (RUN(ph)) for (int rep_ = 0; rep_ < REP_RET2; ++rep_) { LT(); unsigned char* ws = WS();
            ret_out_phase((const bf16*)(ws + WS_P1), (const bf16*)(ws + WS_KVT), (const bf16*)(ws + WS_ST), IN(5) + l * 512, (bf16*)(ws + WS_XN), lds, bid, G, tid, wave, lane); }
        SEAM();
        if (RUN(ph)) { BG(); unsigned char* ws = WS(); unsigned char* wl = ws + WS_W + (size_t)l * W_LAYER;
            const float* modl = (const float*)(ws + WS_MOD) + (size_t)l * 8 * NMOD;
            pg8::Gemm g{(const bf16*)(ws + WS_XN), (const bf16*)(wl + W_O), M, D, D}; pg8::StaticOrder S; S.init(M, D, G, bid);
            pg8::EpiRes E{l == 0 ? IN(0) : (const float*)XO(), XO(), modl + 2 * D};
            pg8::gemm_phase<pg8::EpiRes, pg8::StaticOrder, true, true>(lds, g, S, E);
            { LT(); unsigned char* ws = WS(); const float* modl = (const float*)(ws + WS_MOD) + (size_t)l * 8 * NMOD;
              chain_gemv<1, 4>(lds, IN(6) + (size_t)l * D * D, D, D, (const float*)(ws + CH_Y0), (float*)(ws + CH_X0), l == 0 ? IN(0) : (const float*)(ws + CH_X0), l == 0 ? (size_t)T * D : (size_t)D, modl + 2 * D, bid, G, tid, lane, wave); } }
        SEAM();
        if (RUN(ph)) for (int rep_ = 0; rep_ < REP_NORM; ++rep_) { LT(); unsigned char* ws = WS(); const float* modl = (const float*)(ws + WS_MOD) + (size_t)l * 8 * NMOD;
            norm_mod_phase(XO(), (const float*)(ws + CH_X0), (size_t)D, (float*)(ws + CH_H0), IN(7) + l * D, modl + 3 * D, modl + 4 * D, (bf16*)(ws + WS_XN), gw, NGW, lane); }
        SEAM();
        if (RUN(ph)) for (int rep_ = 0; rep_ < REP_GEMM_UP; ++rep_) { BG(); unsigned char* ws = WS(); unsigned char* wl = ws + WS_W + (size_t)l * W_LAYER;
            pg8::Gemm g{(const bf16*)(ws + WS_XN), (const bf16*)(wl + W_U), M, FF, D}; pg8::StaticOrder S; S.init(M, FF, G, bid);
            pg8::EpiRelu2 E{(bf16*)(ws + WS_H), FF};
            pg8::gemm_phase<pg8::EpiRelu2, pg8::StaticOrder, true, true>(lds, g, S, E);
            { LT(); unsigned char* ws = WS(); chain_gemv<2, 16>(lds, IN(8) + (size_t)l * D * FF, D, FF, (const float*)(ws + CH_H0), (float*)(ws + CH_U0), nullptr, 0, nullptr, bid, G, tid, lane, wave); } }
        SEAM();
        if (RUN(ph)) { BG(); unsigned char* ws = WS(); unsigned char* wl = ws + WS_W + (size_t)l * W_LAYER;
            const float* modl = (const float*)(ws + WS_MOD) + (size_t)l * 8 * NMOD;
            pg8::Gemm g{(const bf16*)(ws + WS_H), (const bf16*)(wl + W_D), M, D, FF}; pg8::StaticOrder S; S.init(M, D, G, bid);
            pg8::EpiRes E{XO(), XO(), modl + 5 * D};
            pg8::gemm_phase<pg8::EpiRes, pg8::StaticOrder, true, true>(lds, g, S, E);
            { LT(); unsigned char* ws = WS(); const float* modl = (const float*)(ws + WS_MOD) + (size_t)l * 8 * NMOD;
              chain_gemv<1, 4>(lds, IN(9) + (size_t)l * FF * D, FF, D, (const float*)(ws + CH_U0), (float*)(ws + CH_X0), (const float*)(ws + CH_X0), (size_t)D, modl + 5 * D, bid, G, tid, lane, wave); } }
        SEAM();
    }
    if (RUN(ph)) { LT(); final_norm_phase(XO(), (const float*)(WS() + CH_X0), IN(12), gw, NGW, lane); }
#undef RUN
#undef SEAM
}

extern "C" void kernel_launch(void* const* d_in, const int* in_sizes, int n_in, void* d_out, int out_size, void* d_ws, size_t ws_size, hipStream_t stream) {
    static int grid = 0;
    if (grid == 0) {
        if (n_in != 13 || in_sizes[0] != M * D || out_size != M * D || ws_size < WS_END) { fprintf(stderr, "kernel_launch: unexpected shapes (n_in %d, in0 %d, out %d, ws %zu < %zu)\n", n_in, n_in > 0 ? in_sizes[0] : -1, out_size, ws_size, (size_t)WS_END); grid = -1; return; }
        int dev = 0, cus = 0, per_cu = 0;
        hipGetDevice(&dev); hipDeviceGetAttribute(&cus, hipDeviceAttributeMultiprocessorCount, dev);
        if (hipFuncSetAttribute((const void*)fwd_kernel, hipFuncAttributeMaxDynamicSharedMemorySize, LDS_BYTES) != hipSuccess) { fprintf(stderr, "kernel_launch: hipFuncSetAttribute failed\n"); grid = -1; return; }
        if (hipOccupancyMaxActiveBlocksPerMultiprocessor(&per_cu, (const void*)fwd_kernel, NTHR, LDS_BYTES) != hipSuccess || per_cu < 1) { fprintf(stderr, "kernel_launch: occupancy query gives %d\n", per_cu); per_cu = 1; }
        (void)hipGetLastError();
        grid = cus * per_cu;
    }
    if (grid < 0) return;
    Args a{};
    for (int i = 0; i < 13; ++i) a.in[i] = (const float*)d_in[i];
    a.out = (float*)d_out; a.ws = (unsigned char*)d_ws; a.ph_lo = 0; a.ph_hi = 1 << 20;
#if defined(MK_PER_PHASE) && MK_PER_PHASE
    for (int k = 0; k < 2 + MK_NANFILL + 8 * DEPTH; ++k) { a.ph_lo = k; a.ph_hi = k + 1; hipLaunchKernelGGL(fwd_kernel, dim3(grid), dim3(NTHR), LDS_BYTES, stream, a); }
#else
    void* args[] = {&a};
    hipError_t e = hipLaunchCooperativeKernel((const void*)fwd_kernel, dim3(grid), dim3(NTHR), args, LDS_BYTES, stream);
    if (e != hipSuccess) fprintf(stderr, "kernel_launch: cooperative launch failed: %s (grid %d)\n", hipGetErrorString(e), grid);
#endif
}
```

```cpp
#include <hip/hip_runtime.h>
#include <hip/hip_cooperative_groups.h>
#include <cstdio>
#include <cstdint>
namespace cg = cooperative_groups;
namespace pg8 {
#define PG8_LAS __attribute__((address_space(3)))
typedef unsigned short bf16_t;
typedef short bf16x8 __attribute__((ext_vector_type(8)));
typedef float f32x4 __attribute__((ext_vector_type(4)));
typedef unsigned u32x4 __attribute__((ext_vector_type(4)));
constexpr int BM = 256, BK = 64, HALF = 128, HTB = HALF * BK * 2  , STAGE_BYTES = 8 * HTB, NXCD = 8, WGM = 4;

__host__ __device__ __forceinline__ int lds_byte(int r, int c) { const int st = (r >> 4) * 2 + (c >> 5), rr = r & 15, cc = c & 31, ob = rr * 64 + cc * 2; return st * 1024 + (ob ^ (((ob >> 9) & 1) << 5)); }
__host__ __device__ __forceinline__ void stage_rc(int b, int& R, int& C) { const int st = b / 1024, sb = b % 1024, swz = sb ^ (((sb >> 9) & 1) << 5); R = (st >> 1) * 16 + swz / 64; C = (st & 1) * 32 + (swz % 64) / 2; }
__host__ __device__ __forceinline__ int perm32(int rho) { const int n = rho >> 4, i = rho & 15; return 8 * (i >> 2) + 4 * n + (i & 3); }

struct Unit { int pm, pn; };
struct Gemm { const bf16_t* A; const bf16_t* Bt; int M, N, K; };

struct StaticOrder {
    int nM, nN, nwg, G, c;
    __host__ __device__ void init(int M, int N, int G_, int c_) { nM = M / BM; nN = N / BM; nwg = nM * nN; G = G_; c = c_; }
    __host__ __device__ bool next(int i, Unit& u) const {
        const long L = (long)i * G + c; if (L >= nwg) return false;
        int wgid = (int)L; { const int q = nwg / NXCD, r = nwg % NXCD, xcd = wgid % NXCD, off = wgid / NXCD; wgid = (xcd < r ? xcd * (q + 1) : r * (q + 1) + (xcd - r) * q) + off; }
        const int nig = WGM * nN, gid = wgid / nig, fm = gid * WGM, gsz = (nM - fm) < WGM ? (nM - fm) : WGM;
        u.pm = fm + ((wgid % nig) % gsz); u.pn = (wgid % nig) / gsz; return true;
    }
    __device__ __forceinline__ void a_ready(const Unit&) const {}
    __device__ __forceinline__ void done(const Unit&) const {}
};

__device__ __forceinline__ unsigned cvt_pk_bf16(float lo, float hi) { unsigned r; asm volatile("v_cvt_pk_bf16_f32 %0, %1, %2" : "=v"(r) : "v"(lo), "v"(hi)); return r; }
typedef unsigned u32x2 __attribute__((ext_vector_type(2)));
struct EpiInProj {
    static constexpr bool PERM = true, AFTER_DRAIN = false;
    bf16_t* O; const float* cs; const float* sn; const float* dq; const float* dk;
    bf16_t* KT; int ldk;
    __device__ __forceinline__ void operator()(const f32x4 (&acc)[2][2][4][2], const Unit& u, int wr, int wc, int fr, int fq) const {
        const int row0 = u.pm * BM + wr * 64 + fr, col0 = u.pn * BM + wc * 32 + 8 * fq;
        const bool rope = (u.pn >= 6 && u.pn < 10);
        const float* dtab = (u.pn >= 8) ? dk : dq;
        const int hb = (u.pn & 1) * 2;
        if (rope) {
#pragma unroll
            for (int ai = 0; ai < 2; ++ai) {
                f32x4 c4[4], s4[4]; float sc[4][2];
#pragma unroll
                for (int m = 0; m < 4; ++m) { const int row = row0 + ai * HALF + m * 16, t = row & 4095, p = t & 127;
                    c4[m] = *(const f32x4*)(cs + t * 64 + 16 * wc + 4 * fq); s4[m] = *(const f32x4*)(sn + t * 64 + 16 * wc + 4 * fq);
                    sc[m][0] = dtab[hb * 128 + p]; sc[m][1] = dtab[(hb + 1) * 128 + p]; }
                __builtin_amdgcn_sched_barrier(0);
#pragma unroll
                for (int m = 0; m < 4; ++m) { bf16_t* rowp = O + (size_t)(row0 + ai * HALF + m * 16) * 3072 + col0;
#pragma unroll
                    for (int bj = 0; bj < 2; ++bj) {
                        const float s_ = sc[m][bj]; const f32x4 cc = c4[m], ss = s4[m];
                        const f32x4 v0 = acc[ai][bj][m][0], v1 = acc[ai][bj][m][1];
                        u32x4 w;
                        w.x = cvt_pk_bf16((v0[0] * cc[0] - v0[1] * ss[0]) * s_, (v0[0] * ss[0] + v0[1] * cc[0]) * s_);
                        w.y = cvt_pk_bf16((v0[2] * cc[1] - v0[3] * ss[1]) * s_, (v0[2] * ss[1] + v0[3] * cc[1]) * s_);
                        w.z = cvt_pk_bf16((v1[0] * cc[2] - v1[1] * ss[2]) * s_, (v1[0] * ss[2] + v1[1] * cc[2]) * s_);
                        w.w = cvt_pk_bf16((v1[2] * cc[3] - v1[3] * ss[3]) * s_, (v1[2] * ss[3] + v1[3] * cc[3]) * s_);
                        *(u32x4*)(rowp + bj * HALF) = w;
                        if (u.pn >= 8) {
                            const int tokrow = row0 + ai * HALF + m * 16, odd = fr & 1;
                            bf16_t* kt = KT + (size_t)((hb + bj) * 128 + wc * 32 + 8 * fq + odd) * ldk + (tokrow - odd);
#pragma unroll
                            for (int q = 0; q < 4; ++q) { const unsigned mine = w[q], other = (unsigned)__shfl_xor((int)mine, 1);
                                const unsigned pr = odd ? ((other >> 16) | (mine & 0xffff0000u)) : ((mine & 0xffffu) | (other << 16));
                                *(unsigned*)(kt + (size_t)(2 * q) * ldk) = pr; }
                        }
                    } }
                __builtin_amdgcn_sched_barrier(0);
            }
        } else if (u.pn >= 12) {
            const int odd = fr & 1;
#pragma unroll
            for (int ai = 0; ai < 2; ++ai)
#pragma unroll
                for (int m = 0; m < 4; ++m) { const int tokrow = row0 + ai * HALF + m * 16;
#pragma unroll
                    for (int bj = 0; bj < 2; ++bj) {
                        const f32x4 v0 = acc[ai][bj][m][0], v1 = acc[ai][bj][m][1];
                        u32x4 w; w.x = cvt_pk_bf16(v0[0], v0[1]); w.y = cvt_pk_bf16(v0[2], v0[3]); w.z = cvt_pk_bf16(v1[0], v1[1]); w.w = cvt_pk_bf16(v1[2], v1[3]);
                        bf16_t* vt = KT + (size_t)(512 + (u.pn - 12) * BM + bj * HALF + wc * 32 + 8 * fq + odd) * ldk + (tokrow - odd);
#pragma unroll
                        for (int q = 0; q < 4; ++q) { const unsigned mine = w[q], other = (unsigned)__shfl_xor((int)mine, 1);
                            const unsigned pr = odd ? ((other >> 16) | (mine & 0xffff0000u)) : ((mine & 0xffffu) | (other << 16));
                            *(unsigned*)(vt + (size_t)(2 * q) * ldk) = pr; }
                    } }
        } else if (u.pn >= 2 && u.pn < 6) {
            const int c0 = (u.pn - 2) * 128 + wc * 16 + 4 * fq;
#pragma unroll
            for (int ai = 0; ai < 2; ++ai)
#pragma unroll
                for (int m = 0; m < 4; ++m) { bf16_t* rowp = O + (size_t)(row0 + ai * HALF + m * 16) * 3072 + 512 + c0;
#pragma unroll
                    for (int bj = 0; bj < 2; ++bj) {
                        const f32x4 v0 = acc[ai][bj][m][0], v1 = acc[ai][bj][m][1];
                        u32x2 w; w.x = cvt_pk_bf16(v0[0] * v0[1], v0[2] * v0[3]); w.y = cvt_pk_bf16(v1[0] * v1[1], v1[2] * v1[3]);
                        *(u32x2*)(rowp + 64 * bj) = w;
                    } }
        } else {
#pragma unroll
            for (int ai = 0; ai < 2; ++ai)
#pragma unroll
                for (int m = 0; m < 4; ++m) { bf16_t* rowp = O + (size_t)(row0 + ai * HALF + m * 16) * 3072 + col0;
#pragma unroll
                    for (int bj = 0; bj < 2; ++bj) {
                        const f32x4 v0 = acc[ai][bj][m][0], v1 = acc[ai][bj][m][1];
                        u32x4 w; w.x = cvt_pk_bf16(v0[0], v0[1]); w.y = cvt_pk_bf16(v0[2], v0[3]); w.z = cvt_pk_bf16(v1[0], v1[1]); w.w = cvt_pk_bf16(v1[2], v1[3]);
                        *(u32x4*)(rowp + bj * HALF) = w;
                    } }
        }
    }
};
struct EpiKVT {
    static constexpr bool PERM = true, AFTER_DRAIN = false;
    bf16_t* O; const float* csT; const float* snT; const float* dk; int ldo;
    __device__ __forceinline__ void operator()(const f32x4 (&acc)[2][2][4][2], const Unit& u, int wr, int wc, int fr, int fq) const {
        const int col0 = u.pn * BM + wc * 32 + 8 * fq;
        if (u.pm < 2) {
#pragma unroll
            for (int bj = 0; bj < 2; ++bj) {
                const int tok = col0 + bj * HALF, t = tok & 4095;
                f32x4 c4[2][2], s4[2][2], d4[2][2];
#pragma unroll
                for (int mm = 0; mm < 2; ++mm)
#pragma unroll
                    for (int n = 0; n < 2; ++n) { const int i = 32 * wr + 16 * mm + fr;
                        c4[mm][n] = *(const f32x4*)(csT + i * (4096 + 32) + t + 4 * n); s4[mm][n] = *(const f32x4*)(snT + i * (4096 + 32) + t + 4 * n);
                        d4[mm][n] = *(const f32x4*)(dk + (2 * u.pm + mm) * 128 + (t & 127) + 4 * n); }
                __builtin_amdgcn_sched_barrier(0);
#pragma unroll
                for (int ai = 0; ai < 2; ++ai)
#pragma unroll
                    for (int mm = 0; mm < 2; ++mm) {
                        const int i = 32 * wr + 16 * mm + fr;
                        bf16_t* r1 = O + (size_t)((2 * u.pm + ai) * 128 + 2 * i) * ldo; bf16_t* r2 = r1 + ldo;
                        u32x4 w1, w2;
#pragma unroll
                        for (int n = 0; n < 2; ++n) {
                            const f32x4 cc = c4[mm][n], ss = s4[mm][n], dd = d4[ai][n];
                            const f32x4 x1 = acc[ai][bj][mm][n], x2 = acc[ai][bj][mm + 2][n];
                            const f32x4 o1 = (x1 * cc - x2 * ss) * dd, o2 = (x1 * ss + x2 * cc) * dd;
                            if (n == 0) { w1.x = cvt_pk_bf16(o1[0], o1[1]); w1.y = cvt_pk_bf16(o1[2], o1[3]); w2.x = cvt_pk_bf16(o2[0], o2[1]); w2.y = cvt_pk_bf16(o2[2], o2[3]); }
                            else        { w1.z = cvt_pk_bf16(o1[0], o1[1]); w1.w = cvt_pk_bf16(o1[2], o1[3]); w2.z = cvt_pk_bf16(o2[0], o2[1]); w2.w = cvt_pk_bf16(o2[2], o2[3]); }
                        }
                        *(u32x4*)(r1 + tok) = w1; *(u32x4*)(r2 + tok) = w2;
                    }
                __builtin_amdgcn_sched_barrier(0);
            }
        } else {
#pragma unroll
            for (int ai = 0; ai < 2; ++ai)
#pragma unroll
                for (int m = 0; m < 4; ++m) {
                    bf16_t* rowp = O + (size_t)(u.pm * BM + ai * HALF + wr * 64 + m * 16 + fr) * ldo + col0;
#pragma unroll
                    for (int bj = 0; bj < 2; ++bj) {
                        const f32x4 v0 = acc[ai][bj][m][0], v1 = acc[ai][bj][m][1];
                        u32x4 w; w.x = cvt_pk_bf16(v0[0], v0[1]); w.y = cvt_pk_bf16(v0[2], v0[3]); w.z = cvt_pk_bf16(v1[0], v1[1]); w.w = cvt_pk_bf16(v1[2], v1[3]);
                        *(u32x4*)(rowp + bj * HALF) = w;
                    }
                }
        }
    }
};
struct EpiVT {
    static constexpr bool PERM = true, AFTER_DRAIN = false;
    bf16_t* O; int ldo;
    __device__ __forceinline__ void operator()(const f32x4 (&acc)[2][2][4][2], const Unit& u, int wr, int wc, int fr, int fq) const {
        const int col0 = u.pn * BM + wc * 32 + 8 * fq;
#pragma unroll
        for (int ai = 0; ai < 2; ++ai)
#pragma unroll
            for (int m = 0; m < 4; ++m) {
                bf16_t* rowp = O + (size_t)(u.pm * BM + ai * HALF + wr * 64 + m * 16 + fr) * ldo + col0;
#pragma unroll
                for (int bj = 0; bj < 2; ++bj) {
                    const f32x4 v0 = acc[ai][bj][m][0], v1 = acc[ai][bj][m][1];
                    u32x4 w; w.x = cvt_pk_bf16(v0[0], v0[1]); w.y = cvt_pk_bf16(v0[2], v0[3]); w.z = cvt_pk_bf16(v1[0], v1[1]); w.w = cvt_pk_bf16(v1[2], v1[3]);
                    *(u32x4*)(rowp + bj * HALF) = w;
                }
            }
    }
};
struct EpiRes {
    static constexpr bool PERM = false, AFTER_DRAIN = false;
    const float* base; float* out; const float* gate;
    __device__ __forceinline__ void operator()(const f32x4 (&acc)[2][2][4][2], const Unit& u, int wr, int wc, int fr, int fq) const {
        const int b = u.pm >> 4, col0 = u.pn * BM + wc * 32 + 4 * fq, row0 = u.pm * BM + wr * 64 + fr;
        f32x4 g[2][2];
#pragma unroll
        for (int bj = 0; bj < 2; ++bj)
#pragma unroll
            for (int n = 0; n < 2; ++n) g[bj][n] = *(const f32x4*)(gate + b * 6144 + col0 + bj * HALF + n * 16);
#pragma unroll
        for (int ai = 0; ai < 2; ++ai) {
            f32x4 bs[4][2][2];
#pragma unroll
            for (int m = 0; m < 4; ++m) { const size_t off = (size_t)(row0 + ai * HALF + m * 16) * 1024 + col0;
#pragma unroll
                for (int bj = 0; bj < 2; ++bj)
#pragma unroll
                    for (int n = 0; n < 2; ++n) bs[m][bj][n] = *(const f32x4*)(base + off + bj * HALF + n * 16); }
            __builtin_amdgcn_sched_barrier(0);
#pragma unroll
            for (int m = 0; m < 4; ++m) { const size_t off = (size_t)(row0 + ai * HALF + m * 16) * 1024 + col0;
#pragma unroll
                for (int bj = 0; bj < 2; ++bj)
#pragma unroll
                    for (int n = 0; n < 2; ++n) *(f32x4*)(out + off + bj * HALF + n * 16) = bs[m][bj][n] + g[bj][n] * acc[ai][bj][m][n]; }
            __builtin_amdgcn_sched_barrier(0);
        }
    }
};
struct EpiRelu2 {
    static constexpr bool PERM = true, AFTER_DRAIN = false;
    bf16_t* O; int ldc;
    __device__ __forceinline__ void operator()(const f32x4 (&acc)[2][2][4][2], const Unit& u, int wr, int wc, int fr, int fq) const {
        const int row0 = u.pm * BM + wr * 64 + fr, col0 = u.pn * BM + wc * 32 + 8 * fq;
#pragma unroll
        for (int ai = 0; ai < 2; ++ai)
#pragma unroll
            for (int m = 0; m < 4; ++m) {
                bf16_t* rowp = O + (size_t)(row0 + ai * HALF + m * 16) * ldc + col0;
#pragma unroll
                for (int bj = 0; bj < 2; ++bj) {
                    f32x4 v0 = acc[ai][bj][m][0], v1 = acc[ai][bj][m][1];
                    v0 = __builtin_elementwise_max(v0, (f32x4){0.f, 0.f, 0.f, 0.f}); v1 = __builtin_elementwise_max(v1, (f32x4){0.f, 0.f, 0.f, 0.f});
                    v0 = v0 * v0; v1 = v1 * v1;
                    u32x4 w; w.x = cvt_pk_bf16(v0[0], v0[1]); w.y = cvt_pk_bf16(v0[2], v0[3]); w.z = cvt_pk_bf16(v1[0], v1[1]); w.w = cvt_pk_bf16(v1[2], v1[3]);
                    __builtin_nontemporal_store(w, (u32x4*)(rowp + bj * HALF));
                }
            }
    }
};
template <class Epi, class Sched, bool ALIGN_EPI = false, bool SP2 = false>
__device__ __forceinline__ void gemm_phase(PG8_LAS unsigned char* lds, const Gemm g, const Sched& S, const Epi& E) {
    int tid = threadIdx.x; asm volatile("" : "+v"(tid));
    const int wid = __builtin_amdgcn_readfirstlane(tid >> 6), lane = tid & 63, wr = wid >> 2, wc = wid & 3, fr = lane & 15, fq = lane >> 4;
    const int K = g.K, nt = K / BK;
    unsigned voffA[2], voffB[2];
#pragma unroll
    for (int i = 0; i < 2; ++i) { int R, C; stage_rc(tid * 16 + i * 8192, R, C); const int Rb = Epi::PERM ? ((R & ~31) + perm32(R & 31)) : R;
        voffA[i] = (unsigned)(R * K + C) * 2u; voffB[i] = (unsigned)(Rb * K + C) * 2u; }
    const size_t kstep = (size_t)(BK * 2);
    const size_t hstep = (size_t)HALF * K * 2;
    const size_t tstep = 2 * hstep;
    const unsigned ldsw = (unsigned)wid * 1024u;
    const int aoff = lds_byte(wr * 64 + fr, fq * 8), boff = lds_byte(wc * 32 + fr, fq * 8);
#define PG8_SA(b, h) (((b) * 2 + (h)) * HTB)
#define PG8_SB(b, h) ((4 + (b) * 2 + (h)) * HTB)
#define PG8_STAGE(bufoff, gbase, voff) do { _Pragma("unroll") for (int _i = 0; _i < 2; ++_i) \
        __builtin_amdgcn_global_load_lds((const unsigned*)((const char*)(gbase) + (voff)[_i]), (PG8_LAS unsigned*)(lds + (bufoff) + ldsw + _i * 8192), 16, 0, 0); } while (0)
#define PG8_LDA(dst, b, h) do { _Pragma("unroll") for (int m = 0; m < 4; ++m) _Pragma("unroll") for (int k = 0; k < 2; ++k) dst[m][k] = *(const PG8_LAS bf16x8*)(lds + PG8_SA(b, h) + aoff + m * 2048 + k * 1024); } while (0)
#define PG8_LDB(dst, b, h) do { _Pragma("unroll") for (int n = 0; n < 2; ++n) _Pragma("unroll") for (int k = 0; k < 2; ++k) dst[n][k] = *(const PG8_LAS bf16x8*)(lds + PG8_SB(b, h) + boff + n * 2048 + k * 1024); } while (0)
#define PG8_MMA(ai, bj, At, Bt) do { __builtin_amdgcn_s_setprio(1); _Pragma("unroll") for (int m = 0; m < 4; ++m) _Pragma("unroll") for (int n = 0; n < 2; ++n) _Pragma("unroll") for (int k = 0; k < 2; ++k) \
        acc[ai][bj][m][n] = __builtin_amdgcn_mfma_f32_16x16x32_bf16(Bt[n][k], At[m][k], acc[ai][bj][m][n], 0, 0, 0); __builtin_amdgcn_s_setprio(0); } while (0)
#define PG8_WAIT_V(n) asm volatile("s_waitcnt vmcnt(" #n ")" ::: "memory")
#define PG8_WAIT_L(n) asm volatile("s_waitcnt lgkmcnt(" #n ")" ::: "memory")
#define PG8_BAR __builtin_amdgcn_s_barrier()
#define PG8_SCHED __builtin_amdgcn_sched_barrier(0)
    Unit cur, nxt; int ui = 0;
    if (!S.next(0, cur)) return;
    f32x4 acc[2][2][4][2];
#pragma unroll
    for (int a = 0; a < 2; ++a)
#pragma unroll
        for (int b = 0; b < 2; ++b)
#pragma unroll
            for (int m = 0; m < 4; ++m)
#pragma unroll
                for (int n = 0; n < 2; ++n) acc[a][b][m][n] = (f32x4){0.f, 0.f, 0.f, 0.f};
    bf16x8 At[4][2], B0[2][2], B1[2][2];
    const char* cA = (const char*)g.A + (size_t)cur.pm * tstep; const char* cB = (const char*)g.Bt + (size_t)cur.pn * tstep;
    S.a_ready(cur);
    if constexpr (SP2) {
        PG8_STAGE(PG8_SB(0, 0), cB, voffB); PG8_STAGE(PG8_SB(0, 1), cB + hstep, voffB); PG8_STAGE(PG8_SA(0, 0), cA, voffA); PG8_STAGE(PG8_SA(0, 1), cA + hstep, voffA);
        if (wr == 1) PG8_BAR;
        PG8_WAIT_V(2); PG8_BAR;
        PG8_STAGE(PG8_SB(1, 0), cB + kstep, voffB); PG8_STAGE(PG8_SA(1, 0), cA + kstep, voffA); PG8_STAGE(PG8_SB(1, 1), cB + hstep + kstep, voffB);
        PG8_WAIT_V(6); PG8_BAR;
    } else {
        PG8_STAGE(PG8_SB(0, 0), cB, voffB); PG8_STAGE(PG8_SA(0, 0), cA, voffA); PG8_STAGE(PG8_SB(0, 1), cB + hstep, voffB); PG8_STAGE(PG8_SA(0, 1), cA + hstep, voffA);
        if (wr == 1) PG8_BAR;
        PG8_WAIT_V(4); PG8_BAR;
        PG8_STAGE(PG8_SB(1, 0), cB + kstep, voffB); PG8_STAGE(PG8_SA(1, 0), cA + kstep, voffA); PG8_STAGE(PG8_SB(1, 1), cB + hstep + kstep, voffB);
        PG8_WAIT_V(6); PG8_BAR;
    }
    for (;;) {
        const bool has_next = S.next(ui + 1, nxt);
        const char* nA = has_next ? (const char*)g.A + (size_t)nxt.pm * tstep : cA; const char* nB = has_next ? (const char*)g.Bt + (size_t)nxt.pn * tstep : cB;
        for (int t = 0; t < nt; t += 2) {
            const bool last = (t == nt - 2);
            const char* a1 = cA + (size_t)(t + 1) * kstep;
            const char* a2 = last ? nA : cA + (size_t)(t + 2) * kstep; const char* b2 = last ? nB : cB + (size_t)(t + 2) * kstep;
            const char* a3 = a2 + kstep; const char* b3 = b2 + kstep;
            if (last && has_next) S.a_ready(nxt);
            if constexpr (SP2) {
            PG8_LDB(B0, 0, 0); PG8_LDB(B1, 0, 1); PG8_SCHED; PG8_LDA(At, 0, 0); PG8_STAGE(PG8_SA(1, 1), a1 + hstep, voffA);
            PG8_WAIT_V(8); PG8_WAIT_L(0); PG8_BAR; PG8_MMA(0, 0, At, B0); PG8_MMA(0, 1, At, B1); PG8_BAR; PG8_SCHED;
            PG8_LDA(At, 0, 1); PG8_STAGE(PG8_SB(0, 0), b2, voffB); PG8_STAGE(PG8_SB(0, 1), b2 + hstep, voffB); PG8_STAGE(PG8_SA(0, 0), a2, voffA);
            PG8_WAIT_V(8); PG8_WAIT_L(0); PG8_BAR; PG8_MMA(1, 0, At, B0); PG8_MMA(1, 1, At, B1); PG8_BAR; PG8_SCHED;
            PG8_LDB(B0, 1, 0); PG8_LDB(B1, 1, 1); PG8_SCHED; PG8_LDA(At, 1, 0); PG8_STAGE(PG8_SA(0, 1), a2 + hstep, voffA);
            PG8_WAIT_V(8); PG8_WAIT_L(0); PG8_BAR; PG8_MMA(0, 0, At, B0); PG8_MMA(0, 1, At, B1); PG8_BAR; PG8_SCHED;
            PG8_LDA(At, 1, 1); PG8_STAGE(PG8_SB(1, 0), b3, voffB); PG8_STAGE(PG8_SB(1, 1), b3 + hstep, voffB); PG8_STAGE(PG8_SA(1, 0), a3, voffA);
            PG8_WAIT_V(8); PG8_WAIT_L(0); PG8_BAR; PG8_MMA(1, 0, At, B0); PG8_MMA(1, 1, At, B1); PG8_BAR; PG8_SCHED;
            } else {
            PG8_LDB(B0, 0, 0); PG8_SCHED; PG8_LDA(At, 0, 0); PG8_STAGE(PG8_SA(1, 1), a1 + hstep, voffA);
            PG8_WAIT_L(8); PG8_BAR; PG8_WAIT_L(0); PG8_MMA(0, 0, At, B0); PG8_BAR; PG8_SCHED;
            PG8_LDB(B1, 0, 1); PG8_STAGE(PG8_SB(0, 0), b2, voffB);
            PG8_BAR; PG8_WAIT_L(0); PG8_MMA(0, 1, At, B1); PG8_BAR;
            PG8_LDA(At, 0, 1); PG8_STAGE(PG8_SA(0, 0), a2, voffA);
            PG8_BAR; PG8_WAIT_L(0); PG8_MMA(1, 0, At, B0); PG8_BAR; PG8_SCHED;
            PG8_STAGE(PG8_SB(0, 1), b2 + hstep, voffB);
            PG8_WAIT_V(6); PG8_BAR; PG8_MMA(1, 1, At, B1); PG8_BAR;
            PG8_LDB(B0, 1, 0); PG8_SCHED; PG8_LDA(At, 1, 0); PG8_STAGE(PG8_SA(0, 1), a2 + hstep, voffA);
            PG8_WAIT_L(8); PG8_BAR; PG8_WAIT_L(0); PG8_MMA(0, 0, At, B0); PG8_BAR; PG8_SCHED;
            PG8_LDB(B1, 1, 1); PG8_STAGE(PG8_SB(1, 0), b3, voffB);
            PG8_BAR; PG8_WAIT_L(0); PG8_MMA(0, 1, At, B1); PG8_BAR;
            PG8_LDA(At, 1, 1); PG8_STAGE(PG8_SA(1, 0), a3, voffA);
            PG8_BAR; PG8_WAIT_L(0); PG8_MMA(1, 0, At, B0); PG8_BAR; PG8_SCHED;
            PG8_STAGE(PG8_SB(1, 1), b3 + hstep, voffB);
            PG8_WAIT_V(6); PG8_BAR; PG8_MMA(1, 1, At, B1); PG8_BAR;
            }
        }
        if constexpr (ALIGN_EPI) { if (wr == 0) PG8_BAR; }
        if constexpr (!Epi::AFTER_DRAIN) { E(acc, cur, wr, wc, fr, fq); S.done(cur); }
        if (!has_next) break;
#pragma unroll
        for (int a = 0; a < 2; ++a)
#pragma unroll
            for (int b = 0; b < 2; ++b)
#pragma unroll
                for (int m = 0; m < 4; ++m)
#pragma unroll
                    for (int n = 0; n < 2; ++n) acc[a][b][m][n] = (f32x4){0.f, 0.f, 0.f, 0.f};
        cur = nxt; cA = nA; cB = nB; ++ui;
        if constexpr (ALIGN_EPI) { if (wr == 1) PG8_BAR; }
    }
    PG8_WAIT_V(0);
    if constexpr (!ALIGN_EPI) { if (wr == 0) PG8_BAR; }
    PG8_BAR;
    if constexpr (Epi::AFTER_DRAIN) { E.fused(acc, cur, wr, wc, fr, fq, lds, wid, lane); S.done(cur); }
#undef PG8_SA
#undef PG8_SB
#undef PG8_STAGE
#undef PG8_LDA
#undef PG8_LDB
#undef PG8_MMA
#undef PG8_WAIT_V
#undef PG8_WAIT_L
#undef PG8_BAR
#undef PG8_SCHED
}
}
#define LAS __attribute__((address_space(3)))
typedef unsigned short bf16;
typedef unsigned v4u __attribute__((ext_vector_type(4)));
typedef unsigned v2u __attribute__((ext_vector_type(2)));
typedef float f32x4 __attribute__((ext_vector_type(4)));
typedef short bf16x8 __attribute__((ext_vector_type(8)));

constexpr int NWAVES = 8, NTHR = NWAVES * 64;
constexpr int BATCH = 8, T = 4096, D = 1024, DEPTH = 4, M = BATCH * T;
constexpr int NHEAD = 4, HD = 128, NCH = T / 128, FF = 4096, NIN = 3584, NMOD = 6 * D;
constexpr int N1 = 3072, N2 = 1024;
constexpr float EPS = 1e-6f;
constexpr size_t MiB = 1u << 20;
constexpr size_t WS_MOD = 0, CTL_ZERO_BYTES = 1 * MiB;
constexpr size_t WS_BAR = 800 * 1024;
constexpr int KVT_LD = M + 2048 + 64, CST_LD = T + 32;
constexpr size_t WS_COS = 1 * MiB, WS_SIN = 2 * MiB, WS_COST = 3 * MiB, WS_SINT = 4 * MiB + 256 * 1024, WS_DQ = 5 * MiB + 512 * 1024, WS_DK = WS_DQ + 4096;
constexpr size_t WS_W = 6 * MiB;
constexpr size_t W_LAYER = 26 * MiB, W_T1 = 0, W_T2 = 6 * MiB, W_O = 8 * MiB, W_U = 10 * MiB, W_D = 18 * MiB;
constexpr size_t WS_XN = WS_W + DEPTH * W_LAYER;
constexpr size_t WS_P1 = WS_XN + 64 * MiB;
constexpr size_t WS_KVT = WS_P1 + 192 * MiB;
constexpr size_t WS_H = WS_P1;
constexpr size_t WS_ST = WS_KVT + 69 * MiB;
constexpr size_t WS_END = WS_ST + 32 * MiB;
constexpr size_t WS_CH = WS_DQ + 65536, CH_X0 = WS_CH, CH_H0 = WS_CH + 32768, CH_P0 = WS_CH + 65536, CH_Y0 = CH_P0 + 8 * 3584 * 4, CH_U0 = CH_Y0 + 32768;
static_assert(CH_U0 + 8 * 4096 * 4 <= 6 * MiB, "chain buffers");
constexpr int LDS_BYTES = 147456;
#ifndef REP_PRO
#define REP_PRO 1
#endif
#ifndef REP_PRO_T
#define REP_PRO_T 1
#endif
#ifndef REP_NORM
#define REP_NORM 1
#endif
#ifndef REP_GEMM_IN
#define REP_GEMM_IN 1
#endif
#ifndef REP_GEMM_UP
#define REP_GEMM_UP 1
#endif
#ifndef REP_RET1
#define REP_RET1 1
#endif
#ifndef REP_RET2
#define REP_RET2 1
#endif
#ifndef XSYNC
#define XSYNC 0
#endif
#ifndef MK_CG_ONLY
#define MK_CG_ONLY 0
#endif
#ifndef MK_NANFILL
#define MK_NANFILL 0
#endif
#ifndef MK_PER_PHASE
#define MK_PER_PHASE 0
#endif

__device__ __forceinline__ unsigned f2bf(float f) { unsigned u = __builtin_bit_cast(unsigned, f); return (u + 0x7fffu + ((u >> 16) & 1u)) >> 16; }
__device__ __forceinline__ unsigned pk2(float lo, float hi) { return f2bf(lo) | (f2bf(hi) << 16); }
__device__ __forceinline__ float bf2f(unsigned short h) { return __builtin_bit_cast(float, (unsigned)h << 16); }
__device__ __forceinline__ float bflo(unsigned w) { return __builtin_bit_cast(float, w << 16); }
__device__ __forceinline__ float bfhi(unsigned w) { return __builtin_bit_cast(float, w & 0xffff0000u); }
#define LDS_WAIT() asm volatile("s_waitcnt lgkmcnt(0)" ::: "memory")
__device__ __forceinline__ float wave_sum(float v) {
#pragma unroll
    for (int o = 1; o < 64; o <<= 1) v += __shfl_xor(v, o);
    return v;
}

__device__ __forceinline__ void tr_load(const float* W, int N, int k0, int n0, LAS float* scr, int lane) {
    float tv[32];
#pragma unroll
    for (int i = 0; i < 32; ++i) tv[i] = W[(size_t)(k0 + 2 * i + (lane >> 5)) * N + n0 + (lane & 31)];
#pragma unroll
    for (int i = 0; i < 32; ++i) scr[(2 * i + (lane >> 5)) * 33 + (lane & 31)] = tv[i];
    LDS_WAIT(); asm volatile("" ::: "memory");
}
__device__ __forceinline__ void win_rows(int c, int& r1, int& r2) {
    const int seg = c >> 9, j = c & 511, head = j >> 7, d = j & 127, i = d & 63, half = d >> 6;
    const int permQ = 2 * i + half, permT = 64 * (i >> 5) + 32 * half + (i & 31);
    r1 = -1; r2 = -1;
    if (seg == 0) r1 = c;
    else if (seg < 3) r1 = 512 + 2 * j + (seg - 1);
    else if (seg == 3) r1 = 1536 + head * 128 + permQ;
    else if (seg == 4) { r1 = 2048 + head * 128 + permQ; (void)permT; }
    else if (seg == 5) r2 = j;
    else r1 = 2560 + j;
}
__device__ __forceinline__ void tr_store_plain(bf16* WT, int K, int k0, int n0, const LAS float* scr, int lane) {
    const int c = lane & 7;
#pragma unroll
    for (int j = 0; j < 4; ++j) { const int n = (lane >> 3) + 8 * j; const LAS float* s = scr + (8 * c) * 33 + n;
        v4u o; o.x = pk2(s[0 * 33], s[1 * 33]); o.y = pk2(s[2 * 33], s[3 * 33]); o.z = pk2(s[4 * 33], s[5 * 33]); o.w = pk2(s[6 * 33], s[7 * 33]);
        *(v4u*)(WT + (size_t)(n0 + n) * K + k0 + 8 * c) = o; }
}
__device__ __forceinline__ void tr_store_win(bf16* Wt1, bf16* Wt2, int k0, int n0, const LAS float* scr, int lane) {
    const int c = lane & 7;
#pragma unroll
    for (int j = 0; j < 4; ++j) { const int n = (lane >> 3) + 8 * j; const LAS float* s = scr + (8 * c) * 33 + n;
        v4u o; o.x = pk2(s[0 * 33], s[1 * 33]); o.y = pk2(s[2 * 33], s[3 * 33]); o.z = pk2(s[4 * 33], s[5 * 33]); o.w = pk2(s[6 * 33], s[7 * 33]);
        int r1, r2; win_rows(n0 + n, r1, r2);
        if (r1 >= 0) *(v4u*)(Wt1 + (size_t)r1 * D + k0 + 8 * c) = o;
        if (r2 >= 0) *(v4u*)(Wt2 + (size_t)r2 * D + k0 + 8 * c) = o; }
}

struct Args { const float* in[13]; float* out; unsigned char* ws; int ph_lo, ph_hi; };

__device__ __forceinline__ void prologue(const Args& a, LAS unsigned char* lds, int tid, int lane, int wave, int bid, int G) {
    unsigned char* ws = a.ws;
    const int gw = bid * NWAVES + wave, NGW = G * NWAVES, gt = bid * NTHR + tid, NGT = G * NTHR;
    {
        float* cs = (float*)(ws + WS_COS); float* sn = (float*)(ws + WS_SIN);
        LAS float* invf = (LAS float*)(lds + 131072 + 256);
        if (tid < 64) invf[tid] = (float)pow(10000.0, -(double)(2 * tid) / 128.0);
        __syncthreads();
        for (int e = gt; e < T * 64; e += NGT) {
            const int t = e >> 6, i = e & 63;
            const double ang = (double)((float)t * invf[i]);
            const double q = __builtin_rint(ang * 0.15915494309189535);
            const float r = (float)(ang - q * 6.283185307179586);
            const float c = cosf(r), s = sinf(r);
            cs[e] = c; sn[e] = s;
        }
        if (bid == 0) {
            float* dq = (float*)(ws + WS_DQ); float* dk = (float*)(ws + WS_DK);
            const int h = tid >> 7, p = tid & 127;
            const double lg = log1p(-exp2(-5.0 - (double)h));
            dq[tid] = (float)exp(lg * (double)(p + 1));
            dk[tid] = (float)(exp(-lg * (double)(p + 1)) * 0.08838834764831845);
            if (p == 0) dk[512 + h] = (float)exp(128.0 * lg);
        }
    }
    {
        LAS float* cact = (LAS float*)(lds + 98304);
        const float* c = a.in[1];
        for (int e = tid; e < BATCH * D; e += NTHR) { const float v = c[e]; cact[e] = v / (1.f + __expf(-v)); }
        __syncthreads();
        float* mod = (float*)(ws + WS_MOD); const float* w_ada = a.in[10]; const float* b_ada = a.in[11];
        LAS float* red = (LAS float*)(lds + 131072 + 256);
        const int col = lane & 31, kh = lane >> 5, k0 = wave * 128;
        for (int it = bid; it < DEPTH * (NMOD / 32); it += G) {
            const int cb = it % (NMOD / 32), l = it / (NMOD / 32);
            const float* W = w_ada + (size_t)l * D * NMOD + (size_t)(k0 + kh) * NMOD + cb * 32 + col;
            float acc[8];
#pragma unroll
            for (int b = 0; b < 8; ++b) acc[b] = 0.f;
            for (int j0 = 0; j0 < 64; j0 += 32) {
                float wv[32];
#pragma unroll
                for (int j = 0; j < 32; ++j) wv[j] = W[(size_t)(2 * (j0 + j)) * NMOD];
#pragma unroll
                for (int j = 0; j < 32; ++j)
#pragma unroll
                    for (int b = 0; b < 8; ++b) acc[b] += cact[b * D + k0 + 2 * (j0 + j) + kh] * wv[j];
            }
#pragma unroll
            for (int b = 0; b < 8; ++b) acc[b] += __shfl_xor(acc[b], 32);
            if (kh == 0) {
#pragma unroll
                for (int b = 0; b < 8; ++b) red[(wave * 8 + b) * 32 + col] = acc[b]; }
            __syncthreads();
            if (tid < 256) { const int b = tid >> 5, c = tid & 31; float s_ = 0.f;
#pragma unroll
                for (int w = 0; w < 8; ++w) s_ += red[(w * 8 + b) * 32 + c];
                mod[((size_t)l * 8 + b) * NMOD + cb * 32 + c] = s_ + b_ada[l * NMOD + cb * 32 + c]; }
            __syncthreads();
        }
    }
    for (int rt_ = 0; rt_ < REP_PRO_T; ++rt_) {
        LAS float* scr = (LAS float*)(lds + wave * 8448);
        constexpr int I_IN = 16 * 112, I_O = 16 * 32, I_U = 16 * 128, I_D = 64 * 32, I_L = I_IN + I_O + I_U + I_D;
        for (int it = gw; it < DEPTH * I_L; it += NGW) {
            const int l = it / I_L; int r = it % I_L;
            unsigned char* wl = ws + WS_W + (size_t)l * W_LAYER;
            if (r < I_IN) { const int kb = r / 112, nb = r % 112; tr_load(a.in[3] + (size_t)l * D * NIN, NIN, 64 * kb, 32 * nb, scr, lane);
                tr_store_win((bf16*)(wl + W_T1), (bf16*)(wl + W_T2), 64 * kb, 32 * nb, scr, lane); LDS_WAIT(); asm volatile("" ::: "memory"); continue; } r -= I_IN;
            if (r < I_O) { const int kb = r / 32, nb = r % 32; tr_load(a.in[6] + (size_t)l * D * D, D, 64 * kb, 32 * nb, scr, lane);
                tr_store_plain((bf16*)(wl + W_O), D, 64 * kb, 32 * nb, scr, lane); LDS_WAIT(); asm volatile("" ::: "memory"); continue; } r -= I_O;
            if (r < I_U) { const int kb = r / 128, nb = r % 128; tr_load(a.in[8] + (size_t)l * D * FF, FF, 64 * kb, 32 * nb, scr, lane);
                tr_store_plain((bf16*)(wl + W_U), D, 64 * kb, 32 * nb, scr, lane); LDS_WAIT(); asm volatile("" ::: "memory"); continue; } r -= I_U;
            { const int kb = r / 32, nb = r % 32; tr_load(a.in[9] + (size_t)l * FF * D, D, 64 * kb, 32 * nb, scr, lane);
                tr_store_plain((bf16*)(wl + W_D), FF, 64 * kb, 32 * nb, scr, lane); LDS_WAIT(); asm volatile("" ::: "memory"); }
        }
    }
}

__device__ __forceinline__ void norm_mod_phase(const float* x, const float* x0src, size_t x0stride, float* h0buf, const float* g, const float* sh, const float* sc, bf16* XN, int gw, int NGW, int lane) {
    const int wpb = NGW / BATCH, rpw = T / wpb;
    const int b = gw / wpb, wi = gw - b * wpb;
    f32x4 gm[4], s0[4];
#pragma unroll
    for (int j = 0; j < 4; ++j) { const int col = 4 * lane + 256 * j; gm[j] = *(const f32x4*)(g + col) * (*(const f32x4*)(sc + b * NMOD + col) + 1.f); s0[j] = *(const f32x4*)(sh + b * NMOD + col); }
    for (int k = 0; k < rpw; k += 4) {
        f32x4 v[4][4];
#pragma unroll
        for (int r = 0; r < 4; ++r) { const int t = wi + wpb * (k + r); const bool t0 = t == 0;
            const f32x4* xr = (const f32x4*)(t0 ? x0src + (size_t)b * x0stride : x + ((size_t)b * T + t) * D) + lane;
#pragma unroll
            for (int j = 0; j < 4; ++j) v[r][j] = xr[64 * j]; }
        __builtin_amdgcn_sched_barrier(0);
#pragma unroll
        for (int r = 0; r < 4; ++r) { const int t = wi + wpb * (k + r); const bool t0 = t == 0; const size_t row = (size_t)b * T + t;
            float ss = 0.f;
#pragma unroll
            for (int j = 0; j < 4; ++j) ss += (v[r][j].x * v[r][j].x + v[r][j].y * v[r][j].y) + (v[r][j].z * v[r][j].z + v[r][j].w * v[r][j].w);
            const float rstd = 1.f / sqrtf(wave_sum(ss) * (1.f / D) + EPS);
#pragma unroll
            for (int j = 0; j < 4; ++j) { const int col = 4 * lane + 256 * j;
                const f32x4 h = v[r][j] * rstd * gm[j] + s0[j];
                v2u o; o.x = pk2(h.x, h.y); o.y = pk2(h.z, h.w);
                *(v2u*)(XN + row * D + col) = o;
                if (t0) *(f32x4*)(h0buf + b * D + col) = h; } }
    }
}
__device__ __forceinline__ void final_norm_phase(float* x, const float* x0buf, const float* g, int gw, int NGW, int lane) {
    f32x4 gg[4];
#pragma unroll
    for (int j = 0; j < 4; ++j) gg[j] = *(const f32x4*)(g + 4 * lane + 256 * j);
    for (int row0 = gw; row0 < M; row0 += 4 * NGW) {
        f32x4 v[4][4];
#pragma unroll
        for (int r = 0; r < 4; ++r) { const int row = row0 + r * NGW; const bool t0 = (row & 4095) == 0;
            const f32x4* xs = t0 ? (const f32x4*)(x0buf + (size_t)(row >> 12) * D) + lane : (const f32x4*)(x + (size_t)row * D) + lane;
#pragma unroll
            for (int j = 0; j < 4; ++j) v[r][j] = xs[64 * j]; }
        __builtin_amdgcn_sched_barrier(0);
#pragma unroll
        for (int r = 0; r < 4; ++r) { const int row = row0 + r * NGW; f32x4* xr = (f32x4*)(x + (size_t)row * D) + lane;
            float ss = 0.f;
#pragma unroll
            for (int j = 0; j < 4; ++j) ss += (v[r][j].x * v[r][j].x + v[r][j].y * v[r][j].y) + (v[r][j].z * v[r][j].z + v[r][j].w * v[r][j].w);
            const float rstd = 1.f / sqrtf(wave_sum(ss) * (1.f / D) + EPS);
#pragma unroll
            for (int j = 0; j < 4; ++j) xr[64 * j] = v[r][j] * rstd * gg[j]; }
    }
}
template <int MODE, int COLS>
__device__ __forceinline__ void chain_gemv(LAS unsigned char* lds, const float* W, int K, int N, const float* in, float* out, const float* base, size_t bstride, const float* gate, int bid, int G, int tid, int lane, int wave) {
    constexpr int KS = 64 / COLS;
    const int nitem = N / COLS;
    if (bid >= nitem) return;
    const int Kw = K >> 3, k0 = wave * Kw, col = lane & (COLS - 1), ksub = lane / COLS;
    LAS float* lin = (LAS float*)lds + wave * (8 * Kw);
    LAS float* red = (LAS float*)(lds + 131072 + 256);
    for (int b = 0; b < 8; ++b) for (int kk = lane; kk < Kw; kk += 64) lin[b * Kw + kk] = in[(size_t)b * K + k0 + kk];
    LDS_WAIT(); asm volatile("" ::: "memory");
    const bool swz = (G == 256 && nitem == 256);
    for (int it = bid; it < nitem; it += G) {
        const int item = swz ? (it & 7) * 32 + (it >> 3) : it;
        const float* Wp = W + (size_t)(k0 + ksub) * N + item * COLS + col;
        float acc[8];
#pragma unroll
        for (int b = 0; b < 8; ++b) acc[b] = 0.f;
        const int nj = Kw / KS;
        constexpr int JB = (COLS == 16) ? 32 : 8;
        for (int j0 = 0; j0 < nj; j0 += JB) {
            float wv[JB];
#pragma unroll
            for (int j = 0; j < JB; ++j) wv[j] = Wp[(size_t)(KS * (j0 + j)) * N];
#pragma unroll
            for (int j = 0; j < JB; ++j)
#pragma unroll
                for (int b = 0; b < 8; ++b) acc[b] += lin[b * Kw + KS * (j0 + j) + ksub] * wv[j];
        }
#pragma unroll
        for (int b = 0; b < 8; ++b) {
#pragma unroll
            for (int o = COLS; o < 64; o <<= 1) acc[b] += __shfl_xor(acc[b], o); }
        if (ksub == 0) {
#pragma unroll
            for (int b = 0; b < 8; ++b) red[(wave * 8 + b) * COLS + col] = acc[b]; }
        __syncthreads();
        if (tid < 8 * COLS) { const int b = tid / COLS, c = tid & (COLS - 1), n = item * COLS + c; float s = 0.f;
#pragma unroll
            for (int w = 0; w < 8; ++w) s += red[(w * 8 + b) * COLS + c];
            if (MODE == 0) out[(size_t)b * N + n] = s;
            else if (MODE == 2) { const float r = fmaxf(s, 0.f); out[(size_t)b * N + n] = r * r; }
            else out[(size_t)b * N + n] = base[(size_t)b * bstride + n] + gate[b * NMOD + n] * s; }
        __syncthreads();
    }
}
__device__ __forceinline__ void chain_mixer(const float* proj0, const float* cw, const float* retg, float* y0, int wave, int lane) {
    const float* p = proj0 + wave * NIN; float* y = y0 + wave * D;
    float pv[56], cwv[8], rg[8];
#pragma unroll
    for (int i = 0; i < 56; ++i) pv[i] = p[lane + 64 * i];
#pragma unroll
    for (int i = 0; i < 8; ++i) { cwv[i] = cw[1024 + lane + 64 * i]; rg[i] = retg[lane + 64 * i]; }
    __builtin_amdgcn_sched_barrier(0);
#pragma unroll
    for (int i = 0; i < 8; ++i) y[lane + 64 * i] = pv[i] * (cwv[i] * (pv[8 + i] * pv[16 + i]));
#pragma unroll
    for (int h = 0; h < NHEAD; ++h) {
        const float q0 = pv[24 + 2 * h], q1 = pv[25 + 2 * h], k0 = pv[32 + 2 * h], k1 = pv[33 + 2 * h], v0 = pv[40 + 2 * h], v1 = pv[41 + 2 * h], g0 = pv[48 + 2 * h], g1 = pv[49 + 2 * h];
        const float score = wave_sum(q0 * k0 + q1 * k1) * 0.08838834764831845f;
        const float o0 = score * v0, o1 = score * v1;
        const float mu = wave_sum(o0 + o1) * (1.f / 128.f);
        const float d0 = o0 - mu, d1 = o1 - mu;
        const float rstd = 1.f / sqrtf(wave_sum(d0 * d0 + d1 * d1) * (1.f / 128.f) + EPS);
        y[512 + h * 128 + lane] = (g0 / (1.f + __expf(-g0))) * (d0 * rstd * rg[2 * h]);
        y[512 + h * 128 + lane + 64] = (g1 / (1.f + __expf(-g1))) * (d1 * rstd * rg[2 * h + 1]);
    }
}

#define MFMA16(a, b, c) __builtin_amdgcn_mfma_f32_16x16x32_bf16(a, b, c, 0, 0, 0)
__device__ __forceinline__ void ret_scan_phase(const bf16* KVT, bf16* ST, const float* cdtab, int bid, int G, int wave, int lane) {
    const int fr = lane & 15, fq = lane >> 4;
    for (int unit = bid; unit < 256; unit += G) {
        const int bh = (unit & 7) * 4 + (unit >> 6), es = (unit >> 3) & 7, h = bh & 3, b = bh >> 2;
        const float cd = cdtab[h];
        const bf16* kp0 = KVT + (size_t)(h * 128 + 16 * wave + fr) * KVT_LD + (size_t)b * T + 8 * fq;
        const bf16* kp1 = kp0 + (size_t)64 * KVT_LD;
        const bf16* vp = KVT + (size_t)(512 + h * 128 + 16 * es + fr) * KVT_LD + (size_t)b * T + 8 * fq;
        bf16* sp = ST + (size_t)((b * 4 + h) * NCH) * 16384 + (16 * es + fr) * 128 + 16 * wave + 4 * fq;
        f32x4 acc0 = {0.f, 0.f, 0.f, 0.f}, acc1 = {0.f, 0.f, 0.f, 0.f};
        bf16x8 x0[2][4], x1[2][4], ys[2][4];
#pragma unroll
        for (int s = 0; s < 2; ++s)
#pragma unroll
            for (int kk = 0; kk < 4; ++kk) { x0[s][kk] = *(const bf16x8*)(kp0 + s * 128 + 32 * kk); x1[s][kk] = *(const bf16x8*)(kp1 + s * 128 + 32 * kk); ys[s][kk] = *(const bf16x8*)(vp + s * 128 + 32 * kk); }
#pragma unroll
        for (int n = 0; n < NCH; n += 2) {
#pragma unroll
            for (int s = 0; s < 2; ++s) {
                { v2u o; o.x = pk2(acc0[0], acc0[1]); o.y = pk2(acc0[2], acc0[3]); *(v2u*)(sp + (size_t)(n + s) * 16384) = o;
                  o.x = pk2(acc1[0], acc1[1]); o.y = pk2(acc1[2], acc1[3]); *(v2u*)(sp + (size_t)(n + s) * 16384 + 64) = o; }
#pragma unroll
                for (int kk = 0; kk < 4; ++kk) { acc0 = MFMA16(x0[s][kk], ys[s][kk], acc0); acc1 = MFMA16(x1[s][kk], ys[s][kk], acc1); }
                acc0 = acc0 * cd; acc1 = acc1 * cd;
                if (n + 2 < NCH) {
#pragma unroll
                    for (int kk = 0; kk < 4; ++kk) { x0[s][kk] = *(const bf16x8*)(kp0 + (n + s + 2) * 128 + 32 * kk); x1[s][kk] = *(const bf16x8*)(kp1 + (n + s + 2) * 128 + 32 * kk); ys[s][kk] = *(const bf16x8*)(vp + (n + s + 2) * 128 + 32 * kk); }
                }
            }
        }
    }
}
__device__ __forceinline__ void conv_phase(const bf16* P1, const float* cw, bf16* Y, int gw, int NGW, int lane) {
    float w0[8], w1[8], w2[8];
#pragma unroll
    for (int k = 0; k < 8; ++k) { w0[k] = cw[8 * lane + k]; w1[k] = cw[512 + 8 * lane + k]; w2[k] = cw[1024 + 8 * lane + k]; }
    for (int run = gw; run < M / 16; run += NGW) {
        const int tok0 = run * 16, t0 = tok0 & 4095;
        float z1[8], z2[8];
#pragma unroll
        for (int k = 0; k < 8; ++k) { z1[k] = 0.f; z2[k] = 0.f; }
        if (t0 != 0) {
            const bf16* r2 = P1 + (size_t)(tok0 - 2) * N1 + 8 * lane; const bf16* r1 = r2 + N1;
            const v4u c2 = *(const v4u*)(r2 + 512), c1 = *(const v4u*)(r1 + 512);
#pragma unroll
            for (int k = 0; k < 4; ++k) { z2[2 * k] = bflo(c2[k]); z2[2 * k + 1] = bfhi(c2[k]); z1[2 * k] = bflo(c1[k]); z1[2 * k + 1] = bfhi(c1[k]); }
        }
        for (int i0 = 0; i0 < 16; i0 += 8) {
            v4u bbv[8], ccv[8];
#pragma unroll
            for (int i = 0; i < 8; ++i) { const bf16* r = P1 + (size_t)(tok0 + i0 + i) * N1 + 8 * lane; bbv[i] = *(const v4u*)r; ccv[i] = *(const v4u*)(r + 512); }
            __builtin_amdgcn_sched_barrier(0);
#pragma unroll
            for (int i = 0; i < 8; ++i) {
                const v4u bb = bbv[i], cc = ccv[i];
                float z0[8], y[8];
#pragma unroll
                for (int k = 0; k < 4; ++k) { z0[2 * k] = bflo(cc[k]); z0[2 * k + 1] = bfhi(cc[k]); }
#pragma unroll
                for (int k = 0; k < 4; ++k) {
                    y[2 * k] = bflo(bb[k]) * (w0[2 * k] * z2[2 * k] + w1[2 * k] * z1[2 * k] + w2[2 * k] * z0[2 * k]);
                    y[2 * k + 1] = bfhi(bb[k]) * (w0[2 * k + 1] * z2[2 * k + 1] + w1[2 * k + 1] * z1[2 * k + 1] + w2[2 * k + 1] * z0[2 * k + 1]);
                }
                v4u o; o.x = pk2(y[0], y[1]); o.y = pk2(y[2], y[3]); o.z = pk2(y[4], y[5]); o.w = pk2(y[6], y[7]);
                *(v4u*)(Y + (size_t)(tok0 + i0 + i) * D + 8 * lane) = o;
#pragma unroll
                for (int k = 0; k < 8; ++k) { z2[k] = z1[k]; z1[k] = z0[k]; }
            }
            __builtin_amdgcn_sched_barrier(0);
        }
    }
}
__device__ __forceinline__ void ret_out_phase(const bf16* P1, const bf16* KVT, const bf16* ST, const float* retg, bf16* Y, LAS unsigned char* lds, int bid, int G, int tid, int wave, int lane) {
    constexpr int NU = BATCH * NHEAD * NCH, PITCH = 272, TILE = 128 * PITCH;
    const int fr = lane & 15, fq = lane >> 4;
    LAS unsigned char* lS = lds; LAS unsigned char* lK = lds + TILE; LAS unsigned char* lV = lds + 2 * TILE;
    v4u pS[4], pK[4], pV[4]; bf16x8 qn[4]; v2u gn[8];
#define R2_ISSUE(unit_, w_) do { const int n_ = (unit_) & 31, h_ = ((unit_) >> 5) & 3, b_ = (unit_) >> 7; const size_t tok0_ = (size_t)b_ * T + 128 * n_; \
        _Pragma("unroll") for (int i = 0; i < 4; ++i) { const int idx = tid + NTHR * i, r = idx >> 4, c = idx & 15; \
            pS[i] = *(const v4u*)(ST + (size_t)(unit_) * 16384 + r * 128 + c * 8); \
            pK[i] = *(const v4u*)(P1 + (tok0_ + r) * N1 + 2048 + h_ * 128 + c * 8); \
            pV[i] = *(const v4u*)(KVT + (size_t)(512 + h_ * 128 + r) * KVT_LD + tok0_ + c * 8); } \
        const bf16* qr_ = P1 + (tok0_ + 16 * (w_) + fr) * N1 + h_ * 128; \
        _Pragma("unroll") for (int kd = 0; kd < 4; ++kd) qn[kd] = *(const bf16x8*)(qr_ + 1536 + 8 * fq + 32 * kd); \
        _Pragma("unroll") for (int te = 0; te < 8; ++te) gn[te] = *(const v2u*)(qr_ + 2560 + 4 * fq + 16 * te); } while (0)
#define R2_WRITE() do { _Pragma("unroll") for (int i = 0; i < 4; ++i) { const int idx = tid + NTHR * i, r = idx >> 4, c = idx & 15; \
            *(LAS v4u*)(lS + r * PITCH + c * 16) = pS[i]; *(LAS v4u*)(lK + r * PITCH + c * 16) = pK[i]; *(LAS v4u*)(lV + r * PITCH + c * 16) = pV[i]; } } while (0)
    int uc = 0, unit = bid;
    if (unit < NU) { R2_ISSUE(unit, wave); R2_WRITE(); }
    __syncthreads();
    for (; unit < NU; unit += G, ++uc) {
        const int w = (uc & 1) ? 7 - wave : wave;
        const int n = unit & 31, h = (unit >> 5) & 3, b = unit >> 7;
        const size_t tok0 = (size_t)b * T + 128 * n;
        bf16x8 qf[4]; v2u gq[8];
#pragma unroll
        for (int kd = 0; kd < 4; ++kd) qf[kd] = qn[kd];
#pragma unroll
        for (int te = 0; te < 8; ++te) gq[te] = gn[te];
        const int nxt = unit + G; const bool has = nxt < NU;
        if (has) { const int wn = ((uc + 1) & 1) ? 7 - wave : wave; R2_ISSUE(nxt, wn); }
        __builtin_amdgcn_sched_barrier(0);
        f32x4 o[8];
#pragma unroll
        for (int te = 0; te < 8; ++te) o[te] = (f32x4){0.f, 0.f, 0.f, 0.f};
#pragma unroll
        for (int te = 0; te < 8; ++te)
#pragma unroll
            for (int kd = 0; kd < 4; ++kd) o[te] = MFMA16(*(const LAS bf16x8*)(lS + (16 * te + fr) * PITCH + kd * 64 + fq * 16), qf[kd], o[te]);
        const int nb = (w >> 1) + 1;
        for (int kk = 0; kk < nb; ++kk) {
            f32x4 sc[2];
#pragma unroll
            for (int t01 = 0; t01 < 2; ++t01) { sc[t01] = (f32x4){0.f, 0.f, 0.f, 0.f};
                const LAS unsigned char* kr = lK + (32 * kk + 8 * (fr >> 2) + (fr & 3) + 4 * t01) * PITCH + fq * 16;
#pragma unroll
                for (int kd = 0; kd < 4; ++kd) sc[t01] = MFMA16(*(const LAS bf16x8*)(kr + kd * 64), qf[kd], sc[t01]); }
            if (kk == nb - 1) { const int i = 16 * w + fr;
#pragma unroll
                for (int t01 = 0; t01 < 2; ++t01)
#pragma unroll
                    for (int r = 0; r < 4; ++r) { const int j = 32 * kk + 8 * fq + 4 * t01 + r; if (j > i) sc[t01][r] = 0.f; } }
            v4u pw; pw.x = pk2(sc[0][0], sc[0][1]); pw.y = pk2(sc[0][2], sc[0][3]); pw.z = pk2(sc[1][0], sc[1][1]); pw.w = pk2(sc[1][2], sc[1][3]);
            const bf16x8 pf = __builtin_bit_cast(bf16x8, pw);
#pragma unroll
            for (int te = 0; te < 8; ++te) o[te] = MFMA16(*(const LAS bf16x8*)(lV + (16 * te + fr) * PITCH + kk * 64 + fq * 16), pf, o[te]);
        }
        float s = 0.f;
#pragma unroll
        for (int te = 0; te < 8; ++te) s += (o[te][0] + o[te][1]) + (o[te][2] + o[te][3]);
        s += __shfl_xor(s, 16); s += __shfl_xor(s, 32);
        const float mean = s * (1.f / 128.f); float q = 0.f;
#pragma unroll
        for (int te = 0; te < 8; ++te) { const f32x4 dlt = o[te] - mean; q += (dlt[0] * dlt[0] + dlt[1] * dlt[1]) + (dlt[2] * dlt[2] + dlt[3] * dlt[3]); }
        q += __shfl_xor(q, 16); q += __shfl_xor(q, 32);
        const float rstd = 1.f / sqrtf(q * (1.f / 128.f) + EPS);
        bf16* yrow = Y + (tok0 + 16 * w + fr) * D + 512 + h * 128 + 4 * fq;
        const float* gg = retg + h * 128 + 4 * fq;
#pragma unroll
        for (int te = 0; te < 8; ++te) {
            const v2u gw2 = gq[te]; const f32x4 g4 = *(const f32x4*)(gg + 16 * te);
            float gv[4] = {bflo(gw2.x), bfhi(gw2.x), bflo(gw2.y), bfhi(gw2.y)}; float y[4];
#pragma unroll
            for (int r = 0; r < 4; ++r) { const float sl = gv[r] / (1.f + __expf(-gv[r])); y[r] = (o[te][r] - mean) * rstd * g4[r] * sl; }
            v2u ov; ov.x = pk2(y[0], y[1]); ov.y = pk2(y[2], y[3]);
            *(v2u*)(yrow + 16 * te) = ov;
        }
        __syncthreads();
        if (has) R2_WRITE();
        __syncthreads();
    }
#undef R2_ISSUE
#undef R2_WRITE
}

#define XB_TMO      128
#define XB_XCNT(j)  (256  + 64 * (j))
#define XB_XSUB(j)  (1280 + 64 * (j))
#define XB_XGEN(j)  (2304 + 64 * (j))
#define XB_TOP      3328
#define XB_TOPGEN   3392
#define XCD_BAR_WORDS 3456
#define XB_SPIN_CAP (1u << 18)

__device__ __forceinline__ unsigned xb_ld(unsigned* p)              { return __hip_atomic_load(p, __ATOMIC_RELAXED, __HIP_MEMORY_SCOPE_AGENT); }
__device__ __forceinline__ unsigned xb_add(unsigned* p, unsigned v) { return __hip_atomic_fetch_add(p, v, __ATOMIC_RELAXED, __HIP_MEMORY_SCOPE_AGENT); }
__device__ __forceinline__ unsigned xb_xcc_id() { return (unsigned)__builtin_amdgcn_s_getreg((3 << 11) | 20) & 0xFu; }
#define XB_SPIN(cond, bar) do { unsigned _sp = 0; while (cond) { __builtin_amdgcn_s_sleep(1); \
    if ((++_sp & 255u) == 0u) { if (xb_ld(&(bar)[XB_TMO])) break; if (_sp > XB_SPIN_CAP) { atomicAdd(&(bar)[XB_TMO], 1u); break; } } } } while (0)

struct XcdBarrier {
    unsigned* bar; unsigned x;
    volatile LAS unsigned* st;
};

__device__ __forceinline__ XcdBarrier xcd_barrier_post(unsigned* bar, volatile LAS unsigned* st) {
    XcdBarrier b; b.bar = bar; b.x = xb_xcc_id(); b.st = st;
    if (threadIdx.x == 0) (void)xb_add(&bar[XB_XCNT(b.x)], 1u);
    return b;
}
__device__ __forceinline__ void xcd_barrier_complete(unsigned* bar, unsigned x, unsigned& nloc, unsigned& nx) {
    const unsigned G = gridDim.x * gridDim.y * gridDim.z;
    unsigned sum, cnt, mine, sp = 0u;
    for (;;) {
        sum = 0u; cnt = 0u; mine = 0u;
#pragma unroll
        for (unsigned j = 0; j < 16; ++j) { const unsigned c = xb_ld(&bar[XB_XCNT(j)]); sum += c; cnt += (c > 0u) ? 1u : 0u; mine = (j == x) ? c : mine; }
        if (sum == G) break;
        __builtin_amdgcn_s_sleep(1);
        if ((++sp & 255u) == 0u) { if (xb_ld(&bar[XB_TMO])) break; if (sp > XB_SPIN_CAP) { atomicAdd(&bar[XB_TMO], 1u); break; } }
    }
    nloc = mine > 0u ? mine : 1u; nx = cnt > 0u ? cnt : 1u;
}

__device__ __forceinline__ void xcd_barrier(const XcdBarrier& b) {
    asm volatile("s_waitcnt vmcnt(0)" ::: "memory");
    __syncthreads();
    if (threadIdx.x == 0) {
        unsigned* bar = b.bar;
        __builtin_amdgcn_s_waitcnt(0);
        unsigned nloc = b.st[0], nx = b.st[1];
        if (nloc == 0u) { xcd_barrier_complete(bar, b.x, nloc, nx); b.st[0] = nloc; b.st[1] = nx; }
        const unsigned old = xb_add(&bar[XB_XSUB(b.x)], 1u);
        const unsigned gen = old / nloc;
        if (old + 1u == (gen + 1u) * nloc) {
            __builtin_amdgcn_fence(__ATOMIC_RELEASE, "agent");
            asm volatile("s_waitcnt vmcnt(0)" ::: "memory");
            const unsigned og = xb_add(&bar[XB_TOP], 1u);
            const unsigned tg = og / nx;
            if (og + 1u == (tg + 1u) * nx) xb_add(&bar[XB_TOPGEN], 1u);
            else XB_SPIN(xb_ld(&bar[XB_TOPGEN]) == tg, bar);
            __builtin_amdgcn_fence(__ATOMIC_ACQUIRE, "agent");
            xb_add(&bar[XB_XGEN(b.x)], 1u);
            asm volatile("s_waitcnt vmcnt(0)" ::: "memory");
        } else {
            XB_SPIN(xb_ld(&bar[XB_XGEN(b.x)]) == gen, bar);
            __builtin_amdgcn_fence(__ATOMIC_ACQUIRE, "agent");
            asm volatile("s_waitcnt vmcnt(0)" ::: "memory");
        }
    }
    __syncthreads();
}

__device__ __forceinline__ unsigned long long tab_get(int k, LAS unsigned char* lds) {
    const LAS unsigned* t = (const LAS unsigned*)(lds + 131072) + 2 * k;
    const unsigned lo = __builtin_amdgcn_readfirstlane(t[0]), hi = __builtin_amdgcn_readfirstlane(t[1]);
    return ((unsigned long long)hi << 32) | lo;
}
__global__ void __launch_bounds__(NTHR, 2) fwd_kernel(Args a) {
    extern __shared__ __attribute__((aligned(16))) unsigned char lds_raw[];
    cg::grid_group grid = cg::this_grid();
    LAS unsigned char* lds = (LAS unsigned char*)lds_raw;
    const int lo = a.ph_lo, hi = a.ph_hi; int ph = 0;
    if (threadIdx.x == 0) {
        LAS unsigned long long* t = (LAS unsigned long long*)(lds + 131072);
#pragma unroll
        for (int i = 0; i < 13; ++i) t[i] = (unsigned long long)a.in[i];
        t[13] = (unsigned long long)a.out; t[14] = (unsigned long long)a.ws;
        ((LAS unsigned*)(lds + 131072 + 128))[0] = 0u; ((LAS unsigned*)(lds + 131072 + 128))[1] = 0u;
    }
    if (blockIdx.x == 0) { unsigned* bw = (unsigned*)(a.ws + WS_BAR); for (int i = threadIdx.x; i < XCD_BAR_WORDS; i += NTHR) bw[i] = 0u; }
    __syncthreads();
#define GASP __attribute__((address_space(1)))
#define IN(k) ((const float*)(const GASP float*)tab_get((k), lds))
#define XO() ((float*)(GASP float*)tab_get(13, lds))
#define WS() ((unsigned char*)(GASP unsigned char*)tab_get(14, lds))
#define RUN(k) (lo <= (k) && (k) < hi)
#define BG() int bid = blockIdx.x, G = gridDim.x; asm volatile("" : "+s"(bid), "+s"(G))
#define LT() BG(); const int NGW = G * NWAVES; int tid = threadIdx.x; asm volatile("" : "+v"(tid)); const int lane = tid & 63, wave = __builtin_amdgcn_readfirstlane(tid >> 6), gw = bid * NWAVES + wave; (void)lane; (void)gw; (void)NGW
#define SEAM() do { ++ph; if (lo < ph && ph < hi) { \
    if (ph == 1 || MK_CG_ONLY) { asm volatile("s_waitcnt vmcnt(0) lgkmcnt(0)" ::: "memory"); __syncthreads();   \
        if (threadIdx.x == 0) { __builtin_amdgcn_fence(__ATOMIC_RELEASE, "agent"); asm volatile("s_waitcnt vmcnt(0)" ::: "memory"); }   \
        for (int xs_ = 0; xs_ < 1 + XSYNC; ++xs_) grid.sync(); \
        if (threadIdx.x == 0) { __builtin_amdgcn_fence(__ATOMIC_ACQUIRE, "agent"); asm volatile("s_waitcnt vmcnt(0)" ::: "memory"); } __syncthreads(); \
        if (!MK_CG_ONLY) (void)xcd_barrier_post((unsigned*)(WS() + WS_BAR), (volatile LAS unsigned*)(lds + 131072 + 128)); } \
    else { XcdBarrier xb_; xb_.bar = (unsigned*)(WS() + WS_BAR); xb_.x = xb_xcc_id(); xb_.st = (volatile LAS unsigned*)(lds + 131072 + 128); \
        for (int xs_ = 0; xs_ < 1 + XSYNC; ++xs_) xcd_barrier(xb_); } } } while (0)

#if defined(MK_NANFILL) && MK_NANFILL
    if (RUN(ph)) { LT(); unsigned char* ws = WS(); v4u* p = (v4u*)(ws + WS_COS); const size_t n16 = (WS_END - WS_COS) / 16; const v4u q = {0xffffffffu, 0xffffffffu, 0xffffffffu, 0xffffffffu};
        for (size_t i = (size_t)bid * NTHR + tid; i < n16; i += (size_t)G * NTHR) p[i] = q;
        { v4u* z = (v4u*)(ws + WS_MOD); const v4u zz = {0u, 0u, 0u, 0u}; for (size_t i = (size_t)bid * NTHR + tid; i < CTL_ZERO_BYTES / 16; i += (size_t)G * NTHR) z[i] = zz; }
        v4u* o = (v4u*)XO(); for (size_t i = (size_t)bid * NTHR + tid; i < (size_t)M * D / 4; i += (size_t)G * NTHR) o[i] = q; }
    SEAM();
#endif
    if (RUN(ph)) for (int rep_ = 0; rep_ < REP_PRO; ++rep_) { LT(); prologue(a, lds, tid, lane, wave, bid, G); }
    SEAM();
    for (int l = 0; l < DEPTH; ++l) {
        if (RUN(ph)) for (int rep_ = 0; rep_ < REP_NORM; ++rep_) { LT(); unsigned char* ws = WS(); const float* modl = (const float*)(ws + WS_MOD) + (size_t)l * 8 * NMOD;
            norm_mod_phase(l == 0 ? IN(0) : (const float*)XO(), l == 0 ? IN(0) : (const float*)(ws + CH_X0), l == 0 ? (size_t)T * D : (size_t)D, (float*)(ws + CH_H0), IN(2) + l * D, modl, modl + D, (bf16*)(ws + WS_XN), gw, NGW, lane); }
        SEAM();
        if (RUN(ph)) for (int rep_ = 0; rep_ < REP_GEMM_IN; ++rep_) {
            { BG(); unsigned char* ws = WS(); unsigned char* wl = ws + WS_W + (size_t)l * W_LAYER;
              static_assert(W_T2 == W_T1 + (size_t)N1 * D * 2, "the v weight rows continue Wt1");
              pg8::Gemm g{(const bf16*)(ws + WS_XN), (const bf16*)(wl + W_T1), M, NIN, D}; pg8::StaticOrder S; S.init(M, NIN, G, bid);
              pg8::EpiInProj E{(bf16*)(ws + WS_P1), (const float*)(ws + WS_COS), (const float*)(ws + WS_SIN), (const float*)(ws + WS_DQ), (const float*)(ws + WS_DK), (bf16*)(ws + WS_KVT), KVT_LD};
              pg8::gemm_phase<pg8::EpiInProj, pg8::StaticOrder, true, true>(lds, g, S, E); }
            { LT(); unsigned char* ws = WS(); chain_gemv<0, 16>(lds, IN(3) + (size_t)l * D * NIN, D, NIN, (const float*)(ws + CH_H0), (float*)(ws + CH_P0), nullptr, 0, nullptr, bid, G, tid, lane, wave); }
        }
        SEAM();
        if (RUN(ph)) for (int rep_ = 0; rep_ < REP_RET1; ++rep_) { LT(); unsigned char* ws = WS();
            if (wave < 4) ret_scan_phase((const bf16*)(ws + WS_KVT), (bf16*)(ws + WS_ST), (const float*)(ws + WS_DK) + 512, bid, G, wave, lane);
            else conv_phase((const bf16*)(ws + WS_P1), IN(4) + l * 3 * 512, (bf16*)(ws + WS_XN), bid * 4 + (wave - 4), G * 4, lane);
            if (bid == G - 1) chain_mixer((const float*)(ws + CH_P0), IN(4) + l * 3 * 512, IN(5) + l * 512, (float*)(ws + CH_Y0), wave, lane); }
        SEAM();
        if (RUN(ph)) for (int rep_ = 0; rep_ < REP_RET2; ++rep_) { LT(); unsigned char* ws = WS();
            ret_out_phase((const bf16*)(ws + WS_P1), (const bf16*)(ws + WS_KVT), (const bf16*)(ws + WS_ST), IN(5) + l * 512, (bf16*)(ws + WS_XN), lds, bid, G, tid, wave, lane); }
        SEAM();
        if (RUN(ph)) { BG(); unsigned char* ws = WS(); unsigned char* wl = ws + WS_W + (size_t)l * W_LAYER;
            const float* modl = (const float*)(ws + WS_MOD) + (size_t)l * 8 * NMOD;
            pg8::Gemm g{(const bf16*)(ws + WS_XN), (const bf16*)(wl + W_O), M, D, D}; pg8::StaticOrder S; S.init(M, D, G, bid);
            pg8::EpiRes E{l == 0 ? IN(0) : (const float*)XO(), XO(), modl + 2 * D};
            pg8::gemm_phase<pg8::EpiRes, pg8::StaticOrder, true, true>(lds, g, S, E);
            { LT(); unsigned char* ws = WS(); const float* modl = (const float*)(ws + WS_MOD) + (size_t)l * 8 * NMOD;
              chain_gemv<1, 4>(lds, IN(6) + (size_t)l * D * D, D, D, (const float*)(ws + CH_Y0), (float*)(ws + CH_X0), l == 0 ? IN(0) : (const float*)(ws + CH_X0), l == 0 ? (size_t)T * D : (size_t)D, modl + 2 * D, bid, G, tid, lane, wave); } }
        SEAM();
        if (RUN(ph)) for (int rep_ = 0; rep_ < REP_NORM; ++rep_) { LT(); unsigned char* ws = WS(); const float* modl = (const float*)(ws + WS_MOD) + (size_t)l * 8 * NMOD;
            norm_mod_phase(XO(), (const float*)(ws + CH_X0), (size_t)D, (float*)(ws + CH_H0), IN(7) + l * D, modl + 3 * D, modl + 4 * D, (bf16*)(ws + WS_XN), gw, NGW, lane); }
        SEAM();
        if (RUN(ph)) for (int rep_ = 0; rep_ < REP_GEMM_UP; ++rep_) { BG(); unsigned char* ws = WS(); unsigned char* wl = ws + WS_W + (size_t)l * W_LAYER;
            pg8::Gemm g{(const bf16*)(ws + WS_XN), (const bf16*)(wl + W_U), M, FF, D}; pg8::StaticOrder S; S.init(M, FF, G, bid);
            pg8::EpiRelu2 E{(bf16*)(ws + WS_H), FF};
            pg8::gemm_phase<pg8::EpiRelu2, pg8::StaticOrder, true, true>(lds, g, S, E);
            { LT(); unsigned char* ws = WS(); chain_gemv<2, 16>(lds, IN(8) + (size_t)l * D * FF, D, FF, (const float*)(ws + CH_H0), (float*)(ws + CH_U0), nullptr, 0, nullptr, bid, G, tid, lane, wave); } }
        SEAM();
        if (RUN(ph)) { BG(); unsigned char* ws = WS(); unsigned char* wl = ws + WS_W + (size_t)l * W_LAYER;
            const float* modl = (const float*)(ws + WS_MOD) + (size_t)l * 8 * NMOD;
            pg8::Gemm g{(const bf16*)(ws + WS_H), (const bf16*)(wl + W_D), M, D, FF}; pg8::StaticOrder S; S.init(M, D, G, bid);
            pg8::EpiRes E{XO(), XO(), modl + 5 * D};
            pg8::gemm_phase<pg8::EpiRes, pg8::StaticOrder, true, true>(lds, g, S, E);
            { LT(); unsigned char* ws = WS(); const float* modl = (const float*)(ws + WS_MOD) + (size_t)l * 8 * NMOD;
              chain_gemv<1, 4>(lds, IN(9) + (size_t)l * FF * D, FF, D, (const float*)(ws + CH_U0), (float*)(ws + CH_X0), (const float*)(ws + CH_X0), (size_t)D, modl + 5 * D, bid, G, tid, lane, wave); } }
        SEAM();
    }
    if (RUN(ph)) { LT(); final_norm_phase(XO(), (const float*)(WS() + CH_X0), IN(12), gw, NGW, lane); }
#undef RUN
#undef SEAM
}

extern "C" void kernel_launch(void* const* d_in, const int* in_sizes, int n_in, void* d_out, int out_size, void* d_ws, size_t ws_size, hipStream_t stream) {
    static int grid = 0;
    if (grid == 0) {
        if (n_in != 13 || in_sizes[0] != M * D || out_size != M * D || ws_size < WS_END) { fprintf(stderr, "kernel_launch: unexpected shapes (n_in %d, in0 %d, out %d, ws %zu < %zu)\n", n_in, n_in > 0 ? in_sizes[0] : -1, out_size, ws_size, (size_t)WS_END); grid = -1; return; }
        int dev = 0, cus = 0, per_cu = 0;
        hipGetDevice(&dev); hipDeviceGetAttribute(&cus, hipDeviceAttributeMultiprocessorCount, dev);
        if (hipFuncSetAttribute((const void*)fwd_kernel, hipFuncAttributeMaxDynamicSharedMemorySize, LDS_BYTES) != hipSuccess) { fprintf(stderr, "kernel_launch: hipFuncSetAttribute failed\n"); grid = -1; return; }
        if (hipOccupancyMaxActiveBlocksPerMultiprocessor(&per_cu, (const void*)fwd_kernel, NTHR, LDS_BYTES) != hipSuccess || per_cu < 1) { fprintf(stderr, "kernel_launch: occupancy query gives %d\n", per_cu); per_cu = 1; }
        (void)hipGetLastError();
        grid = cus * per_cu;
    }
    if (grid < 0) return;
    Args a{};
    for (int i = 0; i < 13; ++i) a.in[i] = (const float*)d_in[i];
    a.out = (float*)d_out; a.ws = (unsigned char*)d_ws; a.ph_lo = 0; a.ph_hi = 1 << 20;
#if defined(MK_PER_PHASE) && MK_PER_PHASE
    for (int k = 0; k < 2 + MK_NANFILL + 8 * DEPTH; ++k) { a.ph_lo = k; a.ph_hi = k + 1; hipLaunchKernelGGL(fwd_kernel, dim3(grid), dim3(NTHR), LDS_BYTES, stream, a); }
#else
    void* args[] = {&a};
    hipError_t e = hipLaunchCooperativeKernel((const void*)fwd_kernel, dim3(grid), dim3(NTHR), args, LDS_BYTES, stream);
    if (e != hipSuccess) fprintf(stderr, "kernel_launch: cooperative launch failed: %s (grid %d)\n", hipGetErrorString(e), grid);
#endif
}
```

```cpp
#include <hip/hip_runtime.h>
#include <hip/hip_cooperative_groups.h>
#include <cstdio>
#include <cstdint>
namespace cg = cooperative_groups;
namespace pg8 {
#define PG8_LAS __attribute__((address_space(3)))
typedef unsigned short bf16_t;
typedef short bf16x8 __attribute__((ext_vector_type(8)));
typedef float f32x4 __attribute__((ext_vector_type(4)));
typedef unsigned u32x4 __attribute__((ext_vector_type(4)));
constexpr int BM = 256, BK = 64, HALF = 128, HTB = HALF * BK * 2  , STAGE_BYTES = 8 * HTB, NXCD = 8, WGM = 4;

__host__ __device__ __forceinline__ int lds_byte(int r, int c) { const int st = (r >> 4) * 2 + (c >> 5), rr = r & 15, cc = c & 31, ob = rr * 64 + cc * 2; return st * 1024 + (ob ^ (((ob >> 9) & 1) << 5)); }
__host__ __device__ __forceinline__ void stage_rc(int b, int& R, int& C) { const int st = b / 1024, sb = b % 1024, swz = sb ^ (((sb >> 9) & 1) << 5); R = (st >> 1) * 16 + swz / 64; C = (st & 1) * 32 + (swz % 64) / 2; }
__host__ __device__ __forceinline__ int perm32(int rho) { const int n = rho >> 4, i = rho & 15; return 8 * (i >> 2) + 4 * n + (i & 3); }

struct Unit { int pm, pn; };
struct Gemm { const bf16_t* A; const bf16_t* Bt; int M, N, K; };

struct StaticOrder {
    int nM, nN, nwg, G, c;
    __host__ __device__ void init(int M, int N, int G_, int c_) { nM = M / BM; nN = N / BM; nwg = nM * nN; G = G_; c = c_; }
    __host__ __device__ bool next(int i, Unit& u) const {
        const long L = (long)i * G + c; if (L >= nwg) return false;
        int wgid = (int)L; { const int q = nwg / NXCD, r = nwg % NXCD, xcd = wgid % NXCD, off = wgid / NXCD; wgid = (xcd < r ? xcd * (q + 1) : r * (q + 1) + (xcd - r) * q) + off; }
        const int nig = WGM * nN, gid = wgid / nig, fm = gid * WGM, gsz = (nM - fm) < WGM ? (nM - fm) : WGM;
        u.pm = fm + ((wgid % nig) % gsz); u.pn = (wgid % nig) / gsz; return true;
    }
    __device__ __forceinline__ void a_ready(const Unit&) const {}
    __device__ __forceinline__ void done(const Unit&) const {}
};

__device__ __forceinline__ unsigned cvt_pk_bf16(float lo, float hi) { unsigned r; asm volatile("v_cvt_pk_bf16_f32 %0, %1, %2" : "=v"(r) : "v"(lo), "v"(hi)); return r; }
typedef unsigned u32x2 __attribute__((ext_vector_type(2)));
struct EpiInProj {
    static constexpr bool PERM = true, AFTER_DRAIN = false;
    bf16_t* O; const float* cs; const float* sn; const float* dq; const float* dk;
    bf16_t* KT; int ldk;
    __device__ __forceinline__ void operator()(const f32x4 (&acc)[2][2][4][2], const Unit& u, int wr, int wc, int fr, int fq) const {
        const int row0 = u.pm * BM + wr * 64 + fr, col0 = u.pn * BM + wc * 32 + 8 * fq;
        const bool rope = (u.pn >= 6 && u.pn < 10);
        const float* dtab = (u.pn >= 8) ? dk : dq;
        const int hb = (u.pn & 1) * 2;
        if (rope) {
#pragma unroll
            for (int ai = 0; ai < 2; ++ai) {
                f32x4 c4[4], s4[4]; float sc[4][2];
#pragma unroll
                for (int m = 0; m < 4; ++m) { const int row = row0 + ai * HALF + m * 16, t = row & 4095, p = t & 127;
                    c4[m] = *(const f32x4*)(cs + t * 64 + 16 * wc + 4 * fq); s4[m] = *(const f32x4*)(sn + t * 64 + 16 * wc + 4 * fq);
                    sc[m][0] = dtab[hb * 128 + p]; sc[m][1] = dtab[(hb + 1) * 128 + p]; }
                __builtin_amdgcn_sched_barrier(0);
#pragma unroll
                for (int m = 0; m < 4; ++m) { bf16_t* rowp = O + (size_t)(row0 + ai * HALF + m * 16) * 3072 + col0;
#pragma unroll
                    for (int bj = 0; bj < 2; ++bj) {
                        const float s_ = sc[m][bj]; const f32x4 cc = c4[m], ss = s4[m];
                        const f32x4 v0 = acc[ai][bj][m][0], v1 = acc[ai][bj][m][1];
                        u32x4 w;
                        w.x = cvt_pk_bf16((v0[0] * cc[0] - v0[1] * ss[0]) * s_, (v0[0] * ss[0] + v0[1] * cc[0]) * s_);
                        w.y = cvt_pk_bf16((v0[2] * cc[1] - v0[3] * ss[1]) * s_, (v0[2] * ss[1] + v0[3] * cc[1]) * s_);
                        w.z = cvt_pk_bf16((v1[0] * cc[2] - v1[1] * ss[2]) * s_, (v1[0] * ss[2] + v1[1] * cc[2]) * s_);
                        w.w = cvt_pk_bf16((v1[2] * cc[3] - v1[3] * ss[3]) * s_, (v1[2] * ss[3] + v1[3] * cc[3]) * s_);
                        *(u32x4*)(rowp + bj * HALF) = w;
                        if (u.pn >= 8) {
                            const int tokrow = row0 + ai * HALF + m * 16, odd = fr & 1;
                            bf16_t* kt = KT + (size_t)((hb + bj) * 128 + wc * 32 + 8 * fq + odd) * ldk + (tokrow - odd);
#pragma unroll
                            for (int q = 0; q < 4; ++q) { const unsigned mine = w[q], other = (unsigned)__shfl_xor((int)mine, 1);
                                const unsigned pr = odd ? ((other >> 16) | (mine & 0xffff0000u)) : ((mine & 0xffffu) | (other << 16));
                                *(unsigned*)(kt + (size_t)(2 * q) * ldk) = pr; }
                        }
                    } }
                __builtin_amdgcn_sched_barrier(0);
            }
        } else if (u.pn >= 12) {
            const int odd = fr & 1;
#pragma unroll
            for (int ai = 0; ai < 2; ++ai)
#pragma unroll
                for (int m = 0; m < 4; ++m) { const int tokrow = row0 + ai * HALF + m * 16;
#pragma unroll
                    for (int bj = 0; bj < 2; ++bj) {
                        const f32x4 v0 = acc[ai][bj][m][0], v1 = acc[ai][bj][m][1];
                        u32x4 w; w.x = cvt_pk_bf16(v0[0], v0[1]); w.y = cvt_pk_bf16(v0[2], v0[3]); w.z = cvt_pk_bf16(v1[0], v1[1]); w.w = cvt_pk_bf16(v1[2], v1[3]);
                        bf16_t* vt = KT + (size_t)(512 + (u.pn - 12) * BM + bj * HALF + wc * 32 + 8 * fq + odd) * ldk + (tokrow - odd);
#pragma unroll
                        for (int q = 0; q < 4; ++q) { const unsigned mine = w[q], other = (unsigned)__shfl_xor((int)mine, 1);
                            const unsigned pr = odd ? ((other >> 16) | (mine & 0xffff0000u)) : ((mine & 0xffffu) | (other << 16));
                            *(unsigned*)(vt + (size_t)(2 * q) * ldk) = pr; }
                    } }
        } else if (u.pn >= 2 && u.pn < 6) {
            const int c0 = (u.pn - 2) * 128 + wc * 16 + 4 * fq;
#pragma unroll
            for (int ai = 0; ai < 2; ++ai)
#pragma unroll
                for (int m = 0; m < 4; ++m) { bf16_t* rowp = O + (size_t)(row0 + ai * HALF + m * 16) * 3072 + 512 + c0;
#pragma unroll
                    for (int bj = 0; bj < 2; ++bj) {
                        const f32x4 v0 = acc[ai][bj][m][0], v1 = acc[ai][bj][m][1];
                        u32x2 w; w.x = cvt_pk_bf16(v0[0] * v0[1], v0[2] * v0[3]); w.y = cvt_pk_bf16(v1[0] * v1[1], v1[2] * v1[3]);
                        *(u32x2*)(rowp + 64 * bj) = w;
                    } }
        } else {
#pragma unroll
            for (int ai = 0; ai < 2; ++ai)
#pragma unroll
                for (int m = 0; m < 4; ++m) { bf16_t* rowp = O + (size_t)(row0 + ai * HALF + m * 16) * 3072 + col0;
#pragma unroll
                    for (int bj = 0; bj < 2; ++bj) {
                        const f32x4 v0 = acc[ai][bj][m][0], v1 = acc[ai][bj][m][1];
                        u32x4 w; w.x = cvt_pk_bf16(v0[0], v0[1]); w.y = cvt_pk_bf16(v0[2], v0[3]); w.z = cvt_pk_bf16(v1[0], v1[1]); w.w = cvt_pk_bf16(v1[2], v1[3]);
                        *(u32x4*)(rowp + bj * HALF) = w;
                    } }
        }
    }
};
struct EpiKVT {
    static constexpr bool PERM = true, AFTER_DRAIN = false;
    bf16_t* O; const float* csT; const float* snT; const float* dk; int ldo;
    __device__ __forceinline__ void operator()(const f32x4 (&acc)[2][2][4][2], const Unit& u, int wr, int wc, int fr, int fq) const {
        const int col0 = u.pn * BM + wc * 32 + 8 * fq;
        if (u.pm < 2) {
#pragma unroll
            for (int bj = 0; bj < 2; ++bj) {
                const int tok = col0 + bj * HALF, t = tok & 4095;
                f32x4 c4[2][2], s4[2][2], d4[2][2];
#pragma unroll
                for (int mm = 0; mm < 2; ++mm)
#pragma unroll
                    for (int n = 0; n < 2; ++n) { const int i = 32 * wr + 16 * mm + fr;
                        c4[mm][n] = *(const f32x4*)(csT + i * (4096 + 32) + t + 4 * n); s4[mm][n] = *(const f32x4*)(snT + i * (4096 + 32) + t + 4 * n);
                        d4[mm][n] = *(const f32x4*)(dk + (2 * u.pm + mm) * 128 + (t & 127) + 4 * n); }
                __builtin_amdgcn_sched_barrier(0);
#pragma unroll
                for (int ai = 0; ai < 2; ++ai)
#pragma unroll
                    for (int mm = 0; mm < 2; ++mm) {
                        const int i = 32 * wr + 16 * mm + fr;
                        bf16_t* r1 = O + (size_t)((2 * u.pm + ai) * 128 + 2 * i) * ldo; bf16_t* r2 = r1 + ldo;
                        u32x4 w1, w2;
#pragma unroll
                        for (int n = 0; n < 2; ++n) {
                            const f32x4 cc = c4[mm][n], ss = s4[mm][n], dd = d4[ai][n];
                            const f32x4 x1 = acc[ai][bj][mm][n], x2 = acc[ai][bj][mm + 2][n];
                            const f32x4 o1 = (x1 * cc - x2 * ss) * dd, o2 = (x1 * ss + x2 * cc) * dd;
                            if (n == 0) { w1.x = cvt_pk_bf16(o1[0], o1[1]); w1.y = cvt_pk_bf16(o1[2], o1[3]); w2.x = cvt_pk_bf16(o2[0], o2[1]); w2.y = cvt_pk_bf16(o2[2], o2[3]); }
                            else        { w1.z = cvt_pk_bf16(o1[0], o1[1]); w1.w = cvt_pk_bf16(o1[2], o1[3]); w2.z = cvt_pk_bf16(o2[0], o2[1]); w2.w = cvt_pk_bf16(o2[2], o2[3]); }
                        }
                        *(u32x4*)(r1 + tok) = w1; *(u32x4*)(r2 + tok) = w2;
                    }
                __builtin_amdgcn_sched_barrier(0);
            }
        } else {
#pragma unroll
            for (int ai = 0; ai < 2; ++ai)
#pragma unroll
                for (int m = 0; m < 4; ++m) {
                    bf16_t* rowp = O + (size_t)(u.pm * BM + ai * HALF + wr * 64 + m * 16 + fr) * ldo + col0;
#pragma unroll
                    for (int bj = 0; bj < 2; ++bj) {
                        const f32x4 v0 = acc[ai][bj][m][0], v1 = acc[ai][bj][m][1];
                        u32x4 w; w.x = cvt_pk_bf16(v0[0], v0[1]); w.y = cvt_pk_bf16(v0[2], v0[3]); w.z = cvt_pk_bf16(v1[0], v1[1]); w.w = cvt_pk_bf16(v1[2], v1[3]);
                        *(u32x4*)(rowp + bj * HALF) = w;
                    }
                }
        }
    }
};
struct EpiVT {
    static constexpr bool PERM = true, AFTER_DRAIN = false;
    bf16_t* O; int ldo;
    __device__ __forceinline__ void operator()(const f32x4 (&acc)[2][2][4][2], const Unit& u, int wr, int wc, int fr, int fq) const {
        const int col0 = u.pn * BM + wc * 32 + 8 * fq;
#pragma unroll
        for (int ai = 0; ai < 2; ++ai)
#pragma unroll
            for (int m = 0; m < 4; ++m) {
                bf16_t* rowp = O + (size_t)(u.pm * BM + ai * HALF + wr * 64 + m * 16 + fr) * ldo + col0;
#pragma unroll
                for (int bj = 0; bj < 2; ++bj) {
                    const f32x4 v0 = acc[ai][bj][m][0], v1 = acc[ai][bj][m][1];
                    u32x4 w; w.x = cvt_pk_bf16(v0[0], v0[1]); w.y = cvt_pk_bf16(v0[2], v0[3]); w.z = cvt_pk_bf16(v1[0], v1[1]); w.w = cvt_pk_bf16(v1[2], v1[3]);
                    *(u32x4*)(rowp + bj * HALF) = w;
                }
            }
    }
};
struct EpiRes {
    static constexpr bool PERM = false, AFTER_DRAIN = false;
    const float* base; float* out; const float* gate;
    __device__ __forceinline__ void operator()(const f32x4 (&acc)[2][2][4][2], const Unit& u, int wr, int wc, int fr, int fq) const {
        const int b = u.pm >> 4, col0 = u.pn * BM + wc * 32 + 4 * fq, row0 = u.pm * BM + wr * 64 + fr;
        f32x4 g[2][2];
#pragma unroll
        for (int bj = 0; bj < 2; ++bj)
#pragma unroll
            for (int n = 0; n < 2; ++n) g[bj][n] = *(const f32x4*)(gate + b * 6144 + col0 + bj * HALF + n * 16);
#pragma unroll
        for (int ai = 0; ai < 2; ++ai) {
            f32x4 bs[4][2][2];
#pragma unroll
            for (int m = 0; m < 4; ++m) { const size_t off = (size_t)(row0 + ai * HALF + m * 16) * 1024 + col0;
#pragma unroll
                for (int bj = 0; bj < 2; ++bj)
#pragma unroll
                    for (int n = 0; n < 2; ++n) bs[m][bj][n] = *(const f32x4*)(base + off + bj * HALF + n * 16); }
            __builtin_amdgcn_sched_barrier(0);
#pragma unroll
            for (int m = 0; m < 4; ++m) { const size_t off = (size_t)(row0 + ai * HALF + m * 16) * 1024 + col0;
#pragma unroll
                for (int bj = 0; bj < 2; ++bj)
#pragma unroll
                    for (int n = 0; n < 2; ++n) *(f32x4*)(out + off + bj * HALF + n * 16) = bs[m][bj][n] + g[bj][n] * acc[ai][bj][m][n]; }
            __builtin_amdgcn_sched_barrier(0);
        }
    }
};
struct EpiRelu2 {
    static constexpr bool PERM = true, AFTER_DRAIN = false;
    bf16_t* O; int ldc;
    __device__ __forceinline__ void operator()(const f32x4 (&acc)[2][2][4][2], const Unit& u, int wr, int wc, int fr, int fq) const {
        const int row0 = u.pm * BM + wr * 64 + fr, col0 = u.pn * BM + wc * 32 + 8 * fq;
#pragma unroll
        for (int ai = 0; ai < 2; ++ai)
#pragma unroll
            for (int m = 0; m < 4; ++m) {
                bf16_t* rowp = O + (size_t)(row0 + ai * HALF + m * 16) * ldc + col0;
#pragma unroll
                for (int bj = 0; bj < 2; ++bj) {
                    f32x4 v0 = acc[ai][bj][m][0], v1 = acc[ai][bj][m][1];
                    v0 = __builtin_elementwise_max(v0, (f32x4){0.f, 0.f, 0.f, 0.f}); v1 = __builtin_elementwise_max(v1, (f32x4){0.f, 0.f, 0.f, 0.f});
                    v0 = v0 * v0; v1 = v1 * v1;
                    u32x4 w; w.x = cvt_pk_bf16(v0[0], v0[1]); w.y = cvt_pk_bf16(v0[2], v0[3]); w.z = cvt_pk_bf16(v1[0], v1[1]); w.w = cvt_pk_bf16(v1[2], v1[3]);
                    __builtin_nontemporal_store(w, (u32x4*)(rowp + bj * HALF));
                }
            }
    }
};
template <class Epi, class Sched, bool ALIGN_EPI = false, bool SP2 = false>
__device__ __forceinline__ void gemm_phase(PG8_LAS unsigned char* lds, const Gemm g, const Sched& S, const Epi& E) {
    int tid = threadIdx.x; asm volatile("" : "+v"(tid));
    const int wid = __builtin_amdgcn_readfirstlane(tid >> 6), lane = tid & 63, wr = wid >> 2, wc = wid & 3, fr = lane & 15, fq = lane >> 4;
    const int K = g.K, nt = K / BK;
    unsigned voffA[2], voffB[2];
#pragma unroll
    for (int i = 0; i < 2; ++i) { int R, C; stage_rc(tid * 16 + i * 8192, R, C); const int Rb = Epi::PERM ? ((R & ~31) + perm32(R & 31)) : R;
        voffA[i] = (unsigned)(R * K + C) * 2u; voffB[i] = (unsigned)(Rb * K + C) * 2u; }
    const size_t kstep = (size_t)(BK * 2);
    const size_t hstep = (size_t)HALF * K * 2;
    const size_t tstep = 2 * hstep;
    const unsigned ldsw = (unsigned)wid * 1024u;
    const int aoff = lds_byte(wr * 64 + fr, fq * 8), boff = lds_byte(wc * 32 + fr, fq * 8);
#define PG8_SA(b, h) (((b) * 2 + (h)) * HTB)
#define PG8_SB(b, h) ((4 + (b) * 2 + (h)) * HTB)
#define PG8_STAGE(bufoff, gbase, voff) do { _Pragma("unroll") for (int _i = 0; _i < 2; ++_i) \
        __builtin_amdgcn_global_load_lds((const unsigned*)((const char*)(gbase) + (voff)[_i]), (PG8_LAS unsigned*)(lds + (bufoff) + ldsw + _i * 8192), 16, 0, 0); } while (0)
#define PG8_LDA(dst, b, h) do { _Pragma("unroll") for (int m = 0; m < 4; ++m) _Pragma("unroll") for (int k = 0; k < 2; ++k) dst[m][k] = *(const PG8_LAS bf16x8*)(lds + PG8_SA(b, h) + aoff + m * 2048 + k * 1024); } while (0)
#define PG8_LDB(dst, b, h) do { _Pragma("unroll") for (int n = 0; n < 2; ++n) _Pragma("unroll") for (int k = 0; k < 2; ++k) dst[n][k] = *(const PG8_LAS bf16x8*)(lds + PG8_SB(b, h) + boff + n * 2048 + k * 1024); } while (0)
#define PG8_MMA(ai, bj, At, Bt) do { __builtin_amdgcn_s_setprio(1); _Pragma("unroll") for (int m = 0; m < 4; ++m) _Pragma("unroll") for (int n = 0; n < 2; ++n) _Pragma("unroll") for (int k = 0; k < 2; ++k) \
        acc[ai][bj][m][n] = __builtin_amdgcn_mfma_f32_16x16x32_bf16(Bt[n][k], At[m][k], acc[ai][bj][m][n], 0, 0, 0); __builtin_amdgcn_s_setprio(0); } while (0)
#define PG8_WAIT_V(n) asm volatile("s_waitcnt vmcnt(" #n ")" ::: "memory")
#define PG8_WAIT_L(n) asm volatile("s_waitcnt lgkmcnt(" #n ")" ::: "memory")
#define PG8_BAR __builtin_amdgcn_s_barrier()
#define PG8_SCHED __builtin_amdgcn_sched_barrier(0)
    Unit cur, nxt; int ui = 0;
    if (!S.next(0, cur)) return;
    f32x4 acc[2][2][4][2];
#pragma unroll
    for (int a = 0; a < 2; ++a)
#pragma unroll
        for (int b = 0; b < 2; ++b)
#pragma unroll
            for (int m = 0; m < 4; ++m)
#pragma unroll
                for (int n = 0; n < 2; ++n) acc[a][b][m][n] = (f32x4){0.f, 0.f, 0.f, 0.f};
    bf16x8 At[4][2], B0[2][2], B1[2][2];
    const char* cA = (const char*)g.A + (size_t)cur.pm * tstep; const char* cB = (const char*)g.Bt + (size_t)cur.pn * tstep;
    S.a_ready(cur);
    if constexpr (SP2) {
        PG8_STAGE(PG8_SB(0, 0), cB, voffB); PG8_STAGE(PG8_SB(0, 1), cB + hstep, voffB); PG8_STAGE(PG8_SA(0, 0), cA, voffA); PG8_STAGE(PG8_SA(0, 1), cA + hstep, voffA);
        if (wr == 1) PG8_BAR;
        PG8_WAIT_V(2); PG8_BAR;
        PG8_STAGE(PG8_SB(1, 0), cB + kstep, voffB); PG8_STAGE(PG8_SA(1, 0), cA + kstep, voffA); PG8_STAGE(PG8_SB(1, 1), cB + hstep + kstep, voffB);
        PG8_WAIT_V(6); PG8_BAR;
    } else {
        PG8_STAGE(PG8_SB(0, 0), cB, voffB); PG8_STAGE(PG8_SA(0, 0), cA, voffA); PG8_STAGE(PG8_SB(0, 1), cB + hstep, voffB); PG8_STAGE(PG8_SA(0, 1), cA + hstep, voffA);
        if (wr == 1) PG8_BAR;
        PG8_WAIT_V(4); PG8_BAR;
        PG8_STAGE(PG8_SB(1, 0), cB + kstep, voffB); PG8_STAGE(PG8_SA(1, 0), cA + kstep, voffA); PG8_STAGE(PG8_SB(1, 1), cB + hstep + kstep, voffB);
        PG8_WAIT_V(6); PG8_BAR;
    }
    for (;;) {
        const bool has_next = S.next(ui + 1, nxt);
        const char* nA = has_next ? (const char*)g.A + (size_t)nxt.pm * tstep : cA; const char* nB = has_next ? (const char*)g.Bt + (size_t)nxt.pn * tstep : cB;
        for (int t = 0; t < nt; t += 2) {
            const bool last = (t == nt - 2);
            const char* a1 = cA + (size_t)(t + 1) * kstep;
            const char* a2 = last ? nA : cA + (size_t)(t + 2) * kstep; const char* b2 = last ? nB : cB + (size_t)(t + 2) * kstep;
            const char* a3 = a2 + kstep; const char* b3 = b2 + kstep;
            if (last && has_next) S.a_ready(nxt);
            if constexpr (SP2) {
            PG8_LDB(B0, 0, 0); PG8_LDB(B1, 0, 1); PG8_SCHED; PG8_LDA(At, 0, 0); PG8_STAGE(PG8_SA(1, 1), a1 + hstep, voffA);
            PG8_WAIT_V(8); PG8_WAIT_L(0); PG8_BAR; PG8_MMA(0, 0, At, B0); PG8_MMA(0, 1, At, B1); PG8_BAR; PG8_SCHED;
            PG8_LDA(At, 0, 1); PG8_STAGE(PG8_SB(0, 0), b2, voffB); PG8_STAGE(PG8_SB(0, 1), b2 + hstep, voffB); PG8_STAGE(PG8_SA(0, 0), a2, voffA);
            PG8_WAIT_V(8); PG8_WAIT_L(0); PG8_BAR; PG8_MMA(1, 0, At, B0); PG8_MMA(1, 1, At, B1); PG8_BAR; PG8_SCHED;
            PG8_LDB(B0, 1, 0); PG8_LDB(B1, 1, 1); PG8_SCHED; PG8_LDA(At, 1, 0); PG8_STAGE(PG8_SA(0, 1), a2 + hstep, voffA);
            PG8_WAIT_V(8); PG8_WAIT_L(0); PG8_BAR; PG8_MMA(0, 0, At, B0); PG8_MMA(0, 1, At, B1); PG8_BAR; PG8_SCHED;
            PG8_LDA(At, 1, 1); PG8_STAGE(PG8_SB(1, 0), b3, voffB); PG8_STAGE(PG8_SB(1, 1), b3 + hstep, voffB); PG8_STAGE(PG8_SA(1, 0), a3, voffA);
            PG8_WAIT_V(8); PG8_WAIT_L(0); PG8_BAR; PG8_MMA(1, 0, At, B0); PG8_MMA(1, 1, At, B1); PG8_BAR; PG8_SCHED;
            } else {
            PG8_LDB(B0, 0, 0); PG8_SCHED; PG8_LDA(At, 0, 0); PG8_STAGE(PG8_SA(1, 1), a1 + hstep, voffA);
            PG8_WAIT_L(8); PG8_BAR; PG8_WAIT_L(0); PG8_MMA(0, 0, At, B0); PG8_BAR; PG8_SCHED;
            PG8_LDB(B1, 0, 1); PG8_STAGE(PG8_SB(0, 0), b2, voffB);
            PG8_BAR; PG8_WAIT_L(0); PG8_MMA(0, 1, At, B1); PG8_BAR;
            PG8_LDA(At, 0, 1); PG8_STAGE(PG8_SA(0, 0), a2, voffA);
            PG8_BAR; PG8_WAIT_L(0); PG8_MMA(1, 0, At, B0); PG8_BAR; PG8_SCHED;
            PG8_STAGE(PG8_SB(0, 1), b2 + hstep, voffB);
            PG8_WAIT_V(6); PG8_BAR; PG8_MMA(1, 1, At, B1); PG8_BAR;
            PG8_LDB(B0, 1, 0); PG8_SCHED; PG8_LDA(At, 1, 0); PG8_STAGE(PG8_SA(0, 1), a2 + hstep, voffA);
            PG8_WAIT_L(8); PG8_BAR; PG8_WAIT_L(0); PG8_MMA(0, 0, At, B0); PG8_BAR; PG8_SCHED;
            PG8_LDB(B1, 1, 1); PG8_STAGE(PG8_SB(1, 0), b3, voffB);
            PG8_BAR; PG8_WAIT_L(0); PG8_MMA(0, 1, At, B1); PG8_BAR;
            PG8_LDA(At, 1, 1); PG8_STAGE(PG8_SA(1, 0), a3, voffA);
            PG8_BAR; PG8_WAIT_L(0); PG8_MMA(1, 0, At, B0); PG8_BAR; PG8_SCHED;
            PG8_STAGE(PG8_SB(1, 1), b3 + hstep, voffB);
            PG8_WAIT_V(6); PG8_BAR; PG8_MMA(1, 1, At, B1); PG8_BAR;
            }
        }
        if constexpr (ALIGN_EPI) { if (wr == 0) PG8_BAR; }
        if constexpr (!Epi::AFTER_DRAIN) { E(acc, cur, wr, wc, fr, fq); S.done(cur); }
        if (!has_next) break;
#pragma unroll
        for (int a = 0; a < 2; ++a)
#pragma unroll
            for (int b = 0; b < 2; ++b)
#pragma unroll
                for (int m = 0; m < 4; ++m)
#pragma unroll
                    for (int n = 0; n < 2; ++n) acc[a][b][m][n] = (f32x4){0.f, 0.f, 0.f, 0.f};
        cur = nxt; cA = nA; cB = nB; ++ui;
        if constexpr (ALIGN_EPI) { if (wr == 1) PG8_BAR; }
    }
    PG8_WAIT_V(0);
    if constexpr (!ALIGN_EPI) { if (wr == 0) PG8_BAR; }
    PG8_BAR;
    if constexpr (Epi::AFTER_DRAIN) { E.fused(acc, cur, wr, wc, fr, fq, lds, wid, lane); S.done(cur); }
#undef PG8_SA
#undef PG8_SB
#undef PG8_STAGE
#undef PG8_LDA
#undef PG8_LDB
#undef PG8_MMA
#undef PG8_WAIT_V
#undef PG8_WAIT_L
#undef PG8_BAR
#undef PG8_SCHED
}
}
#define LAS __attribute__((address_space(3)))
typedef unsigned short bf16;
typedef unsigned v4u __attribute__((ext_vector_type(4)));
typedef unsigned v2u __attribute__((ext_vector_type(2)));
typedef float f32x4 __attribute__((ext_vector_type(4)));
typedef short bf16x8 __attribute__((ext_vector_type(8)));

constexpr int NWAVES = 8, NTHR = NWAVES * 64;
constexpr int BATCH = 8, T = 4096, D = 1024, DEPTH = 4, M = BATCH * T;
constexpr int NHEAD = 4, HD = 128, NCH = T / 128, FF = 4096, NIN = 3584, NMOD = 6 * D;
constexpr int N1 = 3072, N2 = 1024;
constexpr float EPS = 1e-6f;
constexpr size_t MiB = 1u << 20;
constexpr size_t WS_MOD = 0, CTL_ZERO_BYTES = 1 * MiB;
constexpr size_t WS_BAR = 800 * 1024;
constexpr int KVT_LD = M + 2048 + 64, CST_LD = T + 32;
constexpr size_t WS_COS = 1 * MiB, WS_SIN = 2 * MiB, WS_COST = 3 * MiB, WS_SINT = 4 * MiB + 256 * 1024, WS_DQ = 5 * MiB + 512 * 1024, WS_DK = WS_DQ + 4096;
constexpr size_t WS_W = 6 * MiB;
constexpr size_t W_LAYER = 26 * MiB, W_T1 = 0, W_T2 = 6 * MiB, W_O = 8 * MiB, W_U = 10 * MiB, W_D = 18 * MiB;
constexpr size_t WS_XN = WS_W + DEPTH * W_LAYER;
constexpr size_t WS_P1 = WS_XN + 64 * MiB;
constexpr size_t WS_KVT = WS_P1 + 192 * MiB;
constexpr size_t WS_H = WS_P1;
constexpr size_t WS_ST = WS_KVT + 69 * MiB;
constexpr size_t WS_END = WS_ST + 32 * MiB;
constexpr size_t WS_CH = WS_DQ + 65536, CH_X0 = WS_CH, CH_H0 = WS_CH + 32768, CH_P0 = WS_CH + 65536, CH_Y0 = CH_P0 + 8 * 3584 * 4, CH_U0 = CH_Y0 + 32768;
static_assert(CH_U0 + 8 * 4096 * 4 <= 6 * MiB, "chain buffers");
constexpr int LDS_BYTES = 147456;
#ifndef REP_PRO
#define REP_PRO 1
#endif
#ifndef REP_PRO_T
#define REP_PRO_T 1
#endif
#ifndef REP_NORM
#define REP_NORM 1
#endif
#ifndef REP_GEMM_IN
#define REP_GEMM_IN 1
#endif
#ifndef REP_GEMM_UP
#define REP_GEMM_UP 1
#endif
#ifndef REP_RET1
#define REP_RET1 1
#endif
#ifndef REP_RET2
#define REP_RET2 1
#endif
#ifndef XSYNC
#define XSYNC 0
#endif
#ifndef MK_CG_ONLY
#define MK_CG_ONLY 0
#endif
#ifndef MK_NANFILL
#define MK_NANFILL 0
#endif
#ifndef MK_PER_PHASE
#define MK_PER_PHASE 0
#endif

__device__ __forceinline__ unsigned f2bf(float f) { unsigned u = __builtin_bit_cast(unsigned, f); return (u + 0x7fffu + ((u >> 16) & 1u)) >> 16; }
__device__ __forceinline__ unsigned pk2(float lo, float hi) { return f2bf(lo) | (f2bf(hi) << 16); }
__device__ __forceinline__ float bf2f(unsigned short h) { return __builtin_bit_cast(float, (unsigned)h << 16); }
__device__ __forceinline__ float bflo(unsigned w) { return __builtin_bit_cast(float, w << 16); }
__device__ __forceinline__ float bfhi(unsigned w) { return __builtin_bit_cast(float, w & 0xffff0000u); }
#define LDS_WAIT() asm volatile("s_waitcnt lgkmcnt(0)" ::: "memory")
__device__ __forceinline__ float wave_sum(float v) {
#pragma unroll
    for (int o = 1; o < 64; o <<= 1) v += __shfl_xor(v, o);
    return v;
}

__device__ __forceinline__ void tr_load(const float* W, int N, int k0, int n0, LAS float* scr, int lane) {
    float tv[32];
#pragma unroll
    for (int i = 0; i < 32; ++i) tv[i] = W[(size_t)(k0 + 2 * i + (lane >> 5)) * N + n0 + (lane & 31)];
#pragma unroll
    for (int i = 0; i < 32; ++i) scr[(2 * i + (lane >> 5)) * 33 + (lane & 31)] = tv[i];
    LDS_WAIT(); asm volatile("" ::: "memory");
}
__device__ __forceinline__ void win_rows(int c, int& r1, int& r2) {
    const int seg = c >> 9, j = c & 511, head = j >> 7, d = j & 127, i = d & 63, half = d >> 6;
    const int permQ = 2 * i + half, permT = 64 * (i >> 5) + 32 * half + (i & 31);
    r1 = -1; r2 = -1;
    if (seg == 0) r1 = c;
    else if (seg < 3) r1 = 512 + 2 * j + (seg - 1);
    else if (seg == 3) r1 = 1536 + head * 128 + permQ;
    else if (seg == 4) { r1 = 2048 + head * 128 + permQ; (void)permT; }
    else if (seg == 5) r2 = j;
    else r1 = 2560 + j;
}
__device__ __forceinline__ void tr_store_plain(bf16* WT, int K, int k0, int n0, const LAS float* scr, int lane) {
    const int c = lane & 7;
#pragma unroll
    for (int j = 0; j < 4; ++j) { const int n = (lane >> 3) + 8 * j; const LAS float* s = scr + (8 * c) * 33 + n;
        v4u o; o.x = pk2(s[0 * 33], s[1 * 33]); o.y = pk2(s[2 * 33], s[3 * 33]); o.z = pk2(s[4 * 33], s[5 * 33]); o.w = pk2(s[6 * 33], s[7 * 33]);
        *(v4u*)(WT + (size_t)(n0 + n) * K + k0 + 8 * c) = o; }
}
__device__ __forceinline__ void tr_store_win(bf16* Wt1, bf16* Wt2, int k0, int n0, const LAS float* scr, int lane) {
    const int c = lane & 7;
#pragma unroll
    for (int j = 0; j < 4; ++j) { const int n = (lane >> 3) + 8 * j; const LAS float* s = scr + (8 * c) * 33 + n;
        v4u o; o.x = pk2(s[0 * 33], s[1 * 33]); o.y = pk2(s[2 * 33], s[3 * 33]); o.z = pk2(s[4 * 33], s[5 * 33]); o.w = pk2(s[6 * 33], s[7 * 33]);
        int r1, r2; win_rows(n0 + n, r1, r2);
        if (r1 >= 0) *(v4u*)(Wt1 + (size_t)r1 * D + k0 + 8 * c) = o;
        if (r2 >= 0) *(v4u*)(Wt2 + (size_t)r2 * D + k0 + 8 * c) = o; }
}

struct Args { const float* in[13]; float* out; unsigned char* ws; int ph_lo, ph_hi; };

__device__ __forceinline__ void prologue(const Args& a, LAS unsigned char* lds, int tid, int lane, int wave, int bid, int G) {
    unsigned char* ws = a.ws;
    const int gw = bid * NWAVES + wave, NGW = G * NWAVES, gt = bid * NTHR + tid, NGT = G * NTHR;
    {
        float* cs = (float*)(ws + WS_COS); float* sn = (float*)(ws + WS_SIN);
        LAS float* invf = (LAS float*)(lds + 131072 + 256);
        if (tid < 64) invf[tid] = (float)pow(10000.0, -(double)(2 * tid) / 128.0);
        __syncthreads();
        for (int e = gt; e < T * 64; e += NGT) {
            const int t = e >> 6, i = e & 63;
            const double ang = (double)((float)t * invf[i]);
            const double q = __builtin_rint(ang * 0.15915494309189535);
            const float r = (float)(ang - q * 6.283185307179586);
            const float c = cosf(r), s = sinf(r);
            cs[e] = c; sn[e] = s;
        }
        if (bid == 0) {
            float* dq = (float*)(ws + WS_DQ); float* dk = (float*)(ws + WS_DK);
            const int h = tid >> 7, p = tid & 127;
            const double lg = log1p(-exp2(-5.0 - (double)h));
            dq[tid] = (float)exp(lg * (double)(p + 1));
            dk[tid] = (float)(exp(-lg * (double)(p + 1)) * 0.08838834764831845);
            if (p == 0) dk[512 + h] = (float)exp(128.0 * lg);
        }
    }
    {
        LAS float* cact = (LAS float*)(lds + 98304);
        const float* c = a.in[1];
        for (int e = tid; e < BATCH * D; e += NTHR) { const float v = c[e]; cact[e] = v / (1.f + __expf(-v)); }
        __syncthreads();
        float* mod = (float*)(ws + WS_MOD); const float* w_ada = a.in[10]; const float* b_ada = a.in[11];
        LAS float* red = (LAS float*)(lds + 131072 + 256);
        const int col = lane & 31, kh = lane >> 5, k0 = wave * 128;
        for (int it = bid; it < DEPTH * (NMOD / 32); it += G) {
            const int cb = it % (NMOD / 32), l = it / (NMOD / 32);
            const float* W = w_ada + (size_t)l * D * NMOD + (size_t)(k0 + kh) * NMOD + cb * 32 + col;
            float acc[8];
#pragma unroll
            for (int b = 0; b < 8; ++b) acc[b] = 0.f;
            for (int j0 = 0; j0 < 64; j0 += 32) {
                float wv[32];
#pragma unroll
                for (int j = 0; j < 32; ++j) wv[j] = W[(size_t)(2 * (j0 + j)) * NMOD];
#pragma unroll
                for (int j = 0; j < 32; ++j)
#pragma unroll
                    for (int b = 0; b < 8; ++b) acc[b] += cact[b * D + k0 + 2 * (j0 + j) + kh] * wv[j];
            }
#pragma unroll
            for (int b = 0; b < 8; ++b) acc[b] += __shfl_xor(acc[b], 32);
            if (kh == 0) {
#pragma unroll
                for (int b = 0; b < 8; ++b) red[(wave * 8 + b) * 32 + col] = acc[b]; }
            __syncthreads();
            if (tid < 256) { const int b = tid >> 5, c = tid & 31; float s_ = 0.f;
#pragma unroll
                for (int w = 0; w < 8; ++w) s_ += red[(w * 8 + b) * 32 + c];
                mod[((size_t)l * 8 + b) * NMOD + cb * 32 + c] = s_ + b_ada[l * NMOD + cb * 32 + c]; }
            __syncthreads();
        }
    }
    for (int rt_ = 0; rt_ < REP_PRO_T; ++rt_) {
        LAS float* scr = (LAS float*)(lds + wave * 8448);
        constexpr int I_IN = 16 * 112, I_O = 16 * 32, I_U = 16 * 128, I_D = 64 * 32, I_L = I_IN + I_O + I_U + I_D;
        for (int it = gw; it < DEPTH * I_L; it += NGW) {
            const int l = it / I_L; int r = it % I_L;
            unsigned char* wl = ws + WS_W + (size_t)l * W_LAYER;
            if (r < I_IN) { const int kb = r / 112, nb = r % 112; tr_load(a.in[3] + (size_t)l * D * NIN, NIN, 64 * kb, 32 * nb, scr, lane);
                tr_store_win((bf16*)(wl + W_T1), (bf16*)(wl + W_T2), 64 * kb, 32 * nb, scr, lane); LDS_WAIT(); asm volatile("" ::: "memory"); continue; } r -= I_IN;
            if (r < I_O) { const int kb = r / 32, nb = r % 32; tr_load(a.in[6] + (size_t)l * D * D, D, 64 * kb, 32 * nb, scr, lane);
                tr_store_plain((bf16*)(wl + W_O), D, 64 * kb, 32 * nb, scr, lane); LDS_WAIT(); asm volatile("" ::: "memory"); continue; } r -= I_O;
            if (r < I_U) { const int kb = r / 128, nb = r % 128; tr_load(a.in[8] + (size_t)l * D * FF, FF, 64 * kb, 32 * nb, scr, lane);
                tr_store_plain((bf16*)(wl + W_U), D, 64 * kb, 32 * nb, scr, lane); LDS_WAIT(); asm volatile("" ::: "memory"); continue; } r -= I_U;
            { const int kb = r / 32, nb = r % 32; tr_load(a.in[9] + (size_t)l * FF * D, D, 64 * kb, 32 * nb, scr, lane);
                tr_store_plain((bf16*)(wl + W_D), FF, 64 * kb, 32 * nb, scr, lane); LDS_WAIT(); asm volatile("" ::: "memory"); }
        }
    }
}

__device__ __forceinline__ void norm_mod_phase(const float* x, const float* x0src, size_t x0stride, float* h0buf, const float* g, const float* sh, const float* sc, bf16* XN, int gw, int NGW, int lane) {
    const int wpb = NGW / BATCH, rpw = T / wpb;
    const int b = gw / wpb, wi = gw - b * wpb;
    f32x4 gm[4], s0[4];
#pragma unroll
    for (int j = 0; j < 4; ++j) { const int col = 4 * lane + 256 * j; gm[j] = *(const f32x4*)(g + col) * (*(const f32x4*)(sc + b * NMOD + col) + 1.f); s0[j] = *(const f32x4*)(sh + b * NMOD + col); }
    for (int k = 0; k < rpw; k += 4) {
        f32x4 v[4][4];
#pragma unroll
        for (int r = 0; r < 4; ++r) { const int t = wi + wpb * (k + r); const bool t0 = t == 0;
            const f32x4* xr = (const f32x4*)(t0 ? x0src + (size_t)b * x0stride : x + ((size_t)b * T + t) * D) + lane;
#pragma unroll
            for (int j = 0; j < 4; ++j) v[r][j] = xr[64 * j]; }
        __builtin_amdgcn_sched_barrier(0);
#pragma unroll
        for (int r = 0; r < 4; ++r) { const int t = wi + wpb * (k + r); const bool t0 = t == 0; const size_t row = (size_t)b * T + t;
            float ss = 0.f;
#pragma unroll
            for (int j = 0; j < 4; ++j) ss += (v[r][j].x * v[r][j].x + v[r][j].y * v[r][j].y) + (v[r][j].z * v[r][j].z + v[r][j].w * v[r][j].w);
            const float rstd = 1.f / sqrtf(wave_sum(ss) * (1.f / D) + EPS);
#pragma unroll
            for (int j = 0; j < 4; ++j) { const int col = 4 * lane + 256 * j;
                const f32x4 h = v[r][j] * rstd * gm[j] + s0[j];
                v2u o; o.x = pk2(h.x, h.y); o.y = pk2(h.z, h.w);
                *(v2u*)(XN + row * D + col) = o;
                if (t0) *(f32x4*)(h0buf + b * D + col) = h; } }
    }
}
__device__ __forceinline__ void final_norm_phase(float* x, const float* x0buf, const float* g, int gw, int NGW, int lane) {
    f32x4 gg[4];
#pragma unroll
    for (int j = 0; j < 4; ++j) gg[j] = *(const f32x4*)(g + 4 * lane + 256 * j);
    for (int row0 = gw; row0 < M; row0 += 4 * NGW) {
        f32x4 v[4][4];
#pragma unroll
        for (int r = 0; r < 4; ++r) { const int row = row0 + r * NGW; const bool t0 = (row & 4095) == 0;
            const f32x4* xs = t0 ? (const f32x4*)(x0buf + (size_t)(row >> 12) * D) + lane : (const f32x4*)(x + (size_t)row * D) + lane;
#pragma unroll
            for (int j = 0; j < 4; ++j) v[r][j] = xs[64 * j]; }
        __builtin_amdgcn_sched_barrier(0);
#pragma unroll
        for (int r = 0; r < 4; ++r) { const int row = row0 + r * NGW; f32x4* xr = (f32x4*)(x + (size_t)row * D) + lane;
            float ss = 0.f;
#pragma unroll
            for (int j = 0; j < 4; ++j) ss += (v[r][j].x * v[r][j].x + v[r][j].y * v[r][j].y) + (v[r][j].z * v[r][j].z + v[r][j].w * v[r][j].w);
            const float rstd = 1.f / sqrtf(wave_sum(ss) * (1.f / D) + EPS);
#pragma unroll
            for (int j = 0; j < 4; ++j) xr[64 * j] = v[r][j] * rstd * gg[j]; }
    }
}
template <int MODE, int COLS>
__device__ __forceinline__ void chain_gemv(LAS unsigned char* lds, const float* W, int K, int N, const float* in, float* out, const float* base, size_t bstride, const float* gate, int bid, int G, int tid, int lane, int wave) {
    constexpr int KS = 64 / COLS;
    const int nitem = N / COLS;
    if (bid >= nitem) return;
    const int Kw = K >> 3, k0 = wave * Kw, col = lane & (COLS - 1), ksub = lane / COLS;
    LAS float* lin = (LAS float*)lds + wave * (8 * Kw);
    LAS float* red = (LAS float*)(lds + 131072 + 256);
    for (int c0 = 0; c0 < 8 * (Kw >> 6); c0 += 16) {
        float tv[16];
#pragma unroll
        for (int c = 0; c < 16; ++c) { const int cc = c0 + c, b = cc / (Kw >> 6), kk = lane + 64 * (cc % (Kw >> 6)); tv[c] = in[(size_t)b * K + k0 + kk]; }
#pragma unroll
        for (int c = 0; c < 16; ++c) { const int cc = c0 + c, b = cc / (Kw >> 6), kk = lane + 64 * (cc % (Kw >> 6)); lin[b * Kw + kk] = tv[c]; }
    }
    LDS_WAIT(); asm volatile("" ::: "memory");
    const bool swz = (G == 256 && nitem == 256);
    for (int it = bid; it < nitem; it += G) {
        const int item = swz ? (it & 7) * 32 + (it >> 3) : it;
        const float* Wp = W + (size_t)(k0 + ksub) * N + item * COLS + col;
        float acc[8];
#pragma unroll
        for (int b = 0; b < 8; ++b) acc[b] = 0.f;
        const int nj = Kw / KS;
        constexpr int JB = (COLS == 16) ? 32 : 8;
        for (int j0 = 0; j0 < nj; j0 += JB) {
            float wv[JB];
#pragma unroll
            for (int j = 0; j < JB; ++j) wv[j] = Wp[(size_t)(KS * (j0 + j)) * N];
#pragma unroll
            for (int j = 0; j < JB; ++j)
#pragma unroll
                for (int b = 0; b < 8; ++b) acc[b] += lin[b * Kw + KS * (j0 + j) + ksub] * wv[j];
        }
#pragma unroll
        for (int b = 0; b < 8; ++b) {
#pragma unroll
            for (int o = COLS; o < 64; o <<= 1) acc[b] += __shfl_xor(acc[b], o); }
        if (ksub == 0) {
#pragma unroll
            for (int b = 0; b < 8; ++b) red[(wave * 8 + b) * COLS + col] = acc[b]; }
        __syncthreads();
        if (tid < 8 * COLS) { const int b = tid / COLS, c = tid & (COLS - 1), n = item * COLS + c; float s = 0.f;
#pragma unroll
            for (int w = 0; w < 8; ++w) s += red[(w * 8 + b) * COLS + c];
            if (MODE == 0) out[(size_t)b * N + n] = s;
            else if (MODE == 2) { const float r = fmaxf(s, 0.f); out[(size_t)b * N + n] = r * r; }
            else out[(size_t)b * N + n] = base[(size_t)b * bstride + n] + gate[b * NMOD + n] * s; }
        __syncthreads();
    }
}
__device__ __forceinline__ void chain_mixer(const float* proj0, const float* cw, const float* retg, float* y0, int wave, int lane) {
    const float* p = proj0 + wave * NIN; float* y = y0 + wave * D;
    float pv[56], cwv[8], rg[8];
#pragma unroll
    for (int i = 0; i < 56; ++i) pv[i] = p[lane + 64 * i];
#pragma unroll
    for (int i = 0; i < 8; ++i) { cwv[i] = cw[1024 + lane + 64 * i]; rg[i] = retg[lane + 64 * i]; }
    __builtin_amdgcn_sched_barrier(0);
#pragma unroll
    for (int i = 0; i < 8; ++i) y[lane + 64 * i] = pv[i] * (cwv[i] * (pv[8 + i] * pv[16 + i]));
#pragma unroll
    for (int h = 0; h < NHEAD; ++h) {
        const float q0 = pv[24 + 2 * h], q1 = pv[25 + 2 * h], k0 = pv[32 + 2 * h], k1 = pv[33 + 2 * h], v0 = pv[40 + 2 * h], v1 = pv[41 + 2 * h], g0 = pv[48 + 2 * h], g1 = pv[49 + 2 * h];
        const float score = wave_sum(q0 * k0 + q1 * k1) * 0.08838834764831845f;
        const float o0 = score * v0, o1 = score * v1;
        const float mu = wave_sum(o0 + o1) * (1.f / 128.f);
        const float d0 = o0 - mu, d1 = o1 - mu;
        const float rstd = 1.f / sqrtf(wave_sum(d0 * d0 + d1 * d1) * (1.f / 128.f) + EPS);
        y[512 + h * 128 + lane] = (g0 / (1.f + __expf(-g0))) * (d0 * rstd * rg[2 * h]);
        y[512 + h * 128 + lane + 64] = (g1 / (1.f + __expf(-g1))) * (d1 * rstd * rg[2 * h + 1]);
    }
}

#define MFMA16(a, b, c) __builtin_amdgcn_mfma_f32_16x16x32_bf16(a, b, c, 0, 0, 0)
__device__ __forceinline__ void ret_scan_phase(const bf16* KVT, bf16* ST, const float* cdtab, int bid, int G, int wave, int lane) {
    const int fr = lane & 15, fq = lane >> 4;
    for (int unit = bid; unit < 256; unit += G) {
        const int bh = (unit & 7) * 4 + (unit >> 6), es = (unit >> 3) & 7, h = bh & 3, b = bh >> 2;
        const float cd = cdtab[h];
        const bf16* kp0 = KVT + (size_t)(h * 128 + 16 * wave + fr) * KVT_LD + (size_t)b * T + 8 * fq;
        const bf16* kp1 = kp0 + (size_t)64 * KVT_LD;
        const bf16* vp = KVT + (size_t)(512 + h * 128 + 16 * es + fr) * KVT_LD + (size_t)b * T + 8 * fq;
        bf16* sp = ST + (size_t)((b * 4 + h) * NCH) * 16384 + (16 * es + fr) * 128 + 16 * wave + 4 * fq;
        f32x4 acc0 = {0.f, 0.f, 0.f, 0.f}, acc1 = {0.f, 0.f, 0.f, 0.f};
        bf16x8 x0[2][4], x1[2][4], ys[2][4];
#pragma unroll
        for (int s = 0; s < 2; ++s)
#pragma unroll
            for (int kk = 0; kk < 4; ++kk) { x0[s][kk] = *(const bf16x8*)(kp0 + s * 128 + 32 * kk); x1[s][kk] = *(const bf16x8*)(kp1 + s * 128 + 32 * kk); ys[s][kk] = *(const bf16x8*)(vp + s * 128 + 32 * kk); }
#pragma unroll
        for (int n = 0; n < NCH; n += 2) {
#pragma unroll
            for (int s = 0; s < 2; ++s) {
                { v2u o; o.x = pk2(acc0[0], acc0[1]); o.y = pk2(acc0[2], acc0[3]); *(v2u*)(sp + (size_t)(n + s) * 16384) = o;
                  o.x = pk2(acc1[0], acc1[1]); o.y = pk2(acc1[2], acc1[3]); *(v2u*)(sp + (size_t)(n + s) * 16384 + 64) = o; }
#pragma unroll
                for (int kk = 0; kk < 4; ++kk) { acc0 = MFMA16(x0[s][kk], ys[s][kk], acc0); acc1 = MFMA16(x1[s][kk], ys[s][kk], acc1); }
                acc0 = acc0 * cd; acc1 = acc1 * cd;
                if (n + 2 < NCH) {
#pragma unroll
                    for (int kk = 0; kk < 4; ++kk) { x0[s][kk] = *(const bf16x8*)(kp0 + (n + s + 2) * 128 + 32 * kk); x1[s][kk] = *(const bf16x8*)(kp1 + (n + s + 2) * 128 + 32 * kk); ys[s][kk] = *(const bf16x8*)(vp + (n + s + 2) * 128 + 32 * kk); }
                }
            }
        }
    }
}
__device__ __forceinline__ void conv_phase(const bf16* P1, const float* cw, bf16* Y, int gw, int NGW, int lane) {
    float w0[8], w1[8], w2[8];
#pragma unroll
    for (int k = 0; k < 8; ++k) { w0[k] = cw[8 * lane + k]; w1[k] = cw[512 + 8 * lane + k]; w2[k] = cw[1024 + 8 * lane + k]; }
    for (int run = gw; run < M / 16; run += NGW) {
        const int tok0 = run * 16, t0 = tok0 & 4095;
        float z1[8], z2[8];
#pragma unroll
        for (int k = 0; k < 8; ++k) { z1[k] = 0.f; z2[k] = 0.f; }
        if (t0 != 0) {
            const bf16* r2 = P1 + (size_t)(tok0 - 2) * N1 + 8 * lane; const bf16* r1 = r2 + N1;
            const v4u c2 = *(const v4u*)(r2 + 512), c1 = *(const v4u*)(r1 + 512);
#pragma unroll
            for (int k = 0; k < 4; ++k) { z2[2 * k] = bflo(c2[k]); z2[2 * k + 1] = bfhi(c2[k]); z1[2 * k] = bflo(c1[k]); z1[2 * k + 1] = bfhi(c1[k]); }
        }
        for (int i0 = 0; i0 < 16; i0 += 8) {
            v4u bbv[8], ccv[8];
#pragma unroll
            for (int i = 0; i < 8; ++i) { const bf16* r = P1 + (size_t)(tok0 + i0 + i) * N1 + 8 * lane; bbv[i] = *(const v4u*)r; ccv[i] = *(const v4u*)(r + 512); }
            __builtin_amdgcn_sched_barrier(0);
#pragma unroll
            for (int i = 0; i < 8; ++i) {
                const v4u bb = bbv[i], cc = ccv[i];
                float z0[8], y[8];
#pragma unroll
                for (int k = 0; k < 4; ++k) { z0[2 * k] = bflo(cc[k]); z0[2 * k + 1] = bfhi(cc[k]); }
#pragma unroll
                for (int k = 0; k < 4; ++k) {
                    y[2 * k] = bflo(bb[k]) * (w0[2 * k] * z2[2 * k] + w1[2 * k] * z1[2 * k] + w2[2 * k] * z0[2 * k]);
                    y[2 * k + 1] = bfhi(bb[k]) * (w0[2 * k + 1] * z2[2 * k + 1] + w1[2 * k + 1] * z1[2 * k + 1] + w2[2 * k + 1] * z0[2 * k + 1]);
                }
                v4u o; o.x = pk2(y[0], y[1]); o.y = pk2(y[2], y[3]); o.z = pk2(y[4], y[5]); o.w = pk2(y[6], y[7]);
                *(v4u*)(Y + (size_t)(tok0 + i0 + i) * D + 8 * lane) = o;
#pragma unroll
                for (int k = 0; k < 8; ++k) { z2[k] = z1[k]; z1[k] = z0[k]; }
            }
            __builtin_amdgcn_sched_barrier(0);
        }
    }
}
__device__ __forceinline__ void ret_out_phase(const bf16* P1, const bf16* KVT, const bf16* ST, const float* retg, bf16* Y, LAS unsigned char* lds, int bid, int G, int tid, int wave, int lane) {
    constexpr int NU = BATCH * NHEAD * NCH, PITCH = 272, TILE = 128 * PITCH;
    const int fr = lane & 15, fq = lane >> 4;
    LAS unsigned char* lS = lds; LAS unsigned char* lK = lds + TILE; LAS unsigned char* lV = lds + 2 * TILE;
    v4u pS[4], pK[4], pV[4]; bf16x8 qn[4]; v2u gn[8];
#define R2_ISSUE(unit_, w_) do { const int n_ = (unit_) & 31, h_ = ((unit_) >> 5) & 3, b_ = (unit_) >> 7; const size_t tok0_ = (size_t)b_ * T + 128 * n_; \
        _Pragma("unroll") for (int i = 0; i < 4; ++i) { const int idx = tid + NTHR * i, r = idx >> 4, c = idx & 15; \
            pS[i] = *(const v4u*)(ST + (size_t)(unit_) * 16384 + r * 128 + c * 8); \
            pK[i] = *(const v4u*)(P1 + (tok0_ + r) * N1 + 2048 + h_ * 128 + c * 8); \
            pV[i] = *(const v4u*)(KVT + (size_t)(512 + h_ * 128 + r) * KVT_LD + tok0_ + c * 8); } \
        const bf16* qr_ = P1 + (tok0_ + 16 * (w_) + fr) * N1 + h_ * 128; \
        _Pragma("unroll") for (int kd = 0; kd < 4; ++kd) qn[kd] = *(const bf16x8*)(qr_ + 1536 + 8 * fq + 32 * kd); \
        _Pragma("unroll") for (int te = 0; te < 8; ++te) gn[te] = *(const v2u*)(qr_ + 2560 + 4 * fq + 16 * te); } while (0)
#define R2_WRITE() do { _Pragma("unroll") for (int i = 0; i < 4; ++i) { const int idx = tid + NTHR * i, r = idx >> 4, c = idx & 15; \
            *(LAS v4u*)(lS + r * PITCH + c * 16) = pS[i]; *(LAS v4u*)(lK + r * PITCH + c * 16) = pK[i]; *(LAS v4u*)(lV + r * PITCH + c * 16) = pV[i]; } } while (0)
    int uc = 0, unit = bid;
    if (unit < NU) { R2_ISSUE(unit, wave); R2_WRITE(); }
    __syncthreads();
    for (; unit < NU; unit += G, ++uc) {
        const int w = (uc & 1) ? 7 - wave : wave;
        const int n = unit & 31, h = (unit >> 5) & 3, b = unit >> 7;
        const size_t tok0 = (size_t)b * T + 128 * n;
        bf16x8 qf[4]; v2u gq[8];
#pragma unroll
        for (int kd = 0; kd < 4; ++kd) qf[kd] = qn[kd];
#pragma unroll
        for (int te = 0; te < 8; ++te) gq[te] = gn[te];
        const int nxt = unit + G; const bool has = nxt < NU;
        if (has) { const int wn = ((uc + 1) & 1) ? 7 - wave : wave; R2_ISSUE(nxt, wn); }
        __builtin_amdgcn_sched_barrier(0);
        f32x4 o[8];
#pragma unroll
        for (int te = 0; te < 8; ++te) o[te] = (f32x4){0.f, 0.f, 0.f, 0.f};
#pragma unroll
        for (int te = 0; te < 8; ++te)
#pragma unroll
            for (int kd = 0; kd < 4; ++kd) o[te] = MFMA16(*(const LAS bf16x8*)(lS + (16 * te + fr) * PITCH + kd * 64 + fq * 16), qf[kd], o[te]);
        const int nb = (w >> 1) + 1;
        for (int kk = 0; kk < nb; ++kk) {
            f32x4 sc[2];
#pragma unroll
            for (int t01 = 0; t01 < 2; ++t01) { sc[t01] = (f32x4){0.f, 0.f, 0.f, 0.f};
                const LAS unsigned char* kr = lK + (32 * kk + 8 * (fr >> 2) + (fr & 3) + 4 * t01) * PITCH + fq * 16;
#pragma unroll
                for (int kd = 0; kd < 4; ++kd) sc[t01] = MFMA16(*(const LAS bf16x8*)(kr + kd * 64), qf[kd], sc[t01]); }
            if (kk == nb - 1) { const int i = 16 * w + fr;
#pragma unroll
                for (int t01 = 0; t01 < 2; ++t01)
#pragma unroll
                    for (int r = 0; r < 4; ++r) { const int j = 32 * kk + 8 * fq + 4 * t01 + r; if (j > i) sc[t01][r] = 0.f; } }
            v4u pw; pw.x = pk2(sc[0][0], sc[0][1]); pw.y = pk2(sc[0][2], sc[0][3]); pw.z = pk2(sc[1][0], sc[1][1]); pw.w = pk2(sc[1][2], sc[1][3]);
            const bf16x8 pf = __builtin_bit_cast(bf16x8, pw);
#pragma unroll
            for (int te = 0; te < 8; ++te) o[te] = MFMA16(*(const LAS bf16x8*)(lV + (16 * te + fr) * PITCH + kk * 64 + fq * 16), pf, o[te]);
        }
        float s = 0.f;
#pragma unroll
        for (int te = 0; te < 8; ++te) s += (o[te][0] + o[te][1]) + (o[te][2] + o[te][3]);
        s += __shfl_xor(s, 16); s += __shfl_xor(s, 32);
        const float mean = s * (1.f / 128.f); float q = 0.f;
#pragma unroll
        for (int te = 0; te < 8; ++te) { const f32x4 dlt = o[te] - mean; q += (dlt[0] * dlt[0] + dlt[1] * dlt[1]) + (dlt[2] * dlt[2] + dlt[3] * dlt[3]); }
        q += __shfl_xor(q, 16); q += __shfl_xor(q, 32);
        const float rstd = 1.f / sqrtf(q * (1.f / 128.f) + EPS);
        bf16* yrow = Y + (tok0 + 16 * w + fr) * D + 512 + h * 128 + 4 * fq;
        const float* gg = retg + h * 128 + 4 * fq;
#pragma unroll
        for (int te = 0; te < 8; ++te) {
            const v2u gw2 = gq[te]; const f32x4 g4 = *(const f32x4*)(gg + 16 * te);
            float gv[4] = {bflo(gw2.x), bfhi(gw2.x), bflo(gw2.y), bfhi(gw2.y)}; float y[4];
#pragma unroll
            for (int r = 0; r < 4; ++r) { const float sl = gv[r] / (1.f + __expf(-gv[r])); y[r] = (o[te][r] - mean) * rstd * g4[r] * sl; }
            v2u ov; ov.x = pk2(y[0], y[1]); ov.y = pk2(y[2], y[3]);
            *(v2u*)(yrow + 16 * te) = ov;
        }
        __syncthreads();
        if (has) R2_WRITE();
        __syncthreads();
    }
#undef R2_ISSUE
#undef R2_WRITE
}

#define XB_TMO      128
#define XB_XCNT(j)  (256  + 64 * (j))
#define XB_XSUB(j)  (1280 + 64 * (j))
#define XB_XGEN(j)  (2304 + 64 * (j))
#define XB_TOP      3328
#define XB_TOPGEN   3392
#define XCD_BAR_WORDS 3456
#define XB_SPIN_CAP (1u << 18)

__device__ __forceinline__ unsigned xb_ld(unsigned* p)              { return __hip_atomic_load(p, __ATOMIC_RELAXED, __HIP_MEMORY_SCOPE_AGENT); }
__device__ __forceinline__ unsigned xb_add(unsigned* p, unsigned v) { return __hip_atomic_fetch_add(p, v, __ATOMIC_RELAXED, __HIP_MEMORY_SCOPE_AGENT); }
__device__ __forceinline__ unsigned xb_xcc_id() { return (unsigned)__builtin_amdgcn_s_getreg((3 << 11) | 20) & 0xFu; }
#define XB_SPIN(cond, bar) do { unsigned _sp = 0; while (cond) { __builtin_amdgcn_s_sleep(1); \
    if ((++_sp & 255u) == 0u) { if (xb_ld(&(bar)[XB_TMO])) break; if (_sp > XB_SPIN_CAP) { atomicAdd(&(bar)[XB_TMO], 1u); break; } } } } while (0)

struct XcdBarrier {
    unsigned* bar; unsigned x;
    volatile LAS unsigned* st;
};

__device__ __forceinline__ XcdBarrier xcd_barrier_post(unsigned* bar, volatile LAS unsigned* st) {
    XcdBarrier b; b.bar = bar; b.x = xb_xcc_id(); b.st = st;
    if (threadIdx.x == 0) (void)xb_add(&bar[XB_XCNT(b.x)], 1u);
    return b;
}
__device__ __forceinline__ void xcd_barrier_complete(unsigned* bar, unsigned x, unsigned& nloc, unsigned& nx) {
    const unsigned G = gridDim.x * gridDim.y * gridDim.z;
    unsigned sum, cnt, mine, sp = 0u;
    for (;;) {
        sum = 0u; cnt = 0u; mine = 0u;
#pragma unroll
        for (unsigned j = 0; j < 16; ++j) { const unsigned c = xb_ld(&bar[XB_XCNT(j)]); sum += c; cnt += (c > 0u) ? 1u : 0u; mine = (j == x) ? c : mine; }
        if (sum == G) break;
        __builtin_amdgcn_s_sleep(1);
        if ((++sp & 255u) == 0u) { if (xb_ld(&bar[XB_TMO])) break; if (sp > XB_SPIN_CAP) { atomicAdd(&bar[XB_TMO], 1u); break; } }
    }
    nloc = mine > 0u ? mine : 1u; nx = cnt > 0u ? cnt : 1u;
}

__device__ __forceinline__ void xcd_barrier(const XcdBarrier& b) {
    asm volatile("s_waitcnt vmcnt(0)" ::: "memory");
    __syncthreads();
    if (threadIdx.x == 0) {
        unsigned* bar = b.bar;
        __builtin_amdgcn_s_waitcnt(0);
        unsigned nloc = b.st[0], nx = b.st[1];
        if (nloc == 0u) { xcd_barrier_complete(bar, b.x, nloc, nx); b.st[0] = nloc; b.st[1] = nx; }
        const unsigned old = xb_add(&bar[XB_XSUB(b.x)], 1u);
        const unsigned gen = old / nloc;
        if (old + 1u == (gen + 1u) * nloc) {
            __builtin_amdgcn_fence(__ATOMIC_RELEASE, "agent");
            asm volatile("s_waitcnt vmcnt(0)" ::: "memory");
            const unsigned og = xb_add(&bar[XB_TOP], 1u);
            const unsigned tg = og / nx;
            if (og + 1u == (tg + 1u) * nx) xb_add(&bar[XB_TOPGEN], 1u);
            else XB_SPIN(xb_ld(&bar[XB_TOPGEN]) == tg, bar);
            __builtin_amdgcn_fence(__ATOMIC_ACQUIRE, "agent");
            xb_add(&bar[XB_XGEN(b.x)], 1u);
            asm volatile("s_waitcnt vmcnt(0)" ::: "memory");
        } else {
            XB_SPIN(xb_ld(&bar[XB_XGEN(b.x)]) == gen, bar);
            __builtin_amdgcn_fence(__ATOMIC_ACQUIRE, "agent");
            asm volatile("s_waitcnt vmcnt(0)" ::: "memory");
        }
    }
    __syncthreads();
}

__device__ __forceinline__ unsigned long long tab_get(int k, LAS unsigned char* lds) {
    const LAS unsigned* t = (const LAS unsigned*)(lds + 131072) + 2 * k;
    const unsigned lo = __builtin_amdgcn_readfirstlane(t[0]), hi = __builtin_amdgcn_readfirstlane(t[1]);
    return ((unsigned long long)hi << 32) | lo;
}
__global__ void __launch_bounds__(NTHR, 2) fwd_kernel(Args a) {
    extern __shared__ __attribute__((aligned(16))) unsigned char lds_raw[];
    cg::grid_group grid = cg::this_grid();
    LAS unsigned char* lds = (LAS unsigned char*)lds_raw;
    const int lo = a.ph_lo, hi = a.ph_hi; int ph = 0;
    if (threadIdx.x == 0) {
        LAS unsigned long long* t = (LAS unsigned long long*)(lds + 131072);
#pragma unroll
        for (int i = 0; i < 13; ++i) t[i] = (unsigned long long)a.in[i];
        t[13] = (unsigned long long)a.out; t[14] = (unsigned long long)a.ws;
        ((LAS unsigned*)(lds + 131072 + 128))[0] = 0u; ((LAS unsigned*)(lds + 131072 + 128))[1] = 0u;
    }
    if (blockIdx.x == 0) { unsigned* bw = (unsigned*)(a.ws + WS_BAR); for (int i = threadIdx.x; i < XCD_BAR_WORDS; i += NTHR) bw[i] = 0u; }
    __syncthreads();
#define GASP __attribute__((address_space(1)))
#define IN(k) ((const float*)(const GASP float*)tab_get((k), lds))
#define XO() ((float*)(GASP float*)tab_get(13, lds))
#define WS() ((unsigned char*)(GASP unsigned char*)tab_get(14, lds))
#define RUN(k) (lo <= (k) && (k) < hi)
#define BG() int bid = blockIdx.x, G = gridDim.x; asm volatile("" : "+s"(bid), "+s"(G))
#define LT() BG(); const int NGW = G * NWAVES; int tid = threadIdx.x; asm volatile("" : "+v"(tid)); const int lane = tid & 63, wave = __builtin_amdgcn_readfirstlane(tid >> 6), gw = bid * NWAVES + wave; (void)lane; (void)gw; (void)NGW
#define SEAM() do { ++ph; if (lo < ph && ph < hi) { \
    if (ph == 1 || MK_CG_ONLY) { asm volatile("s_waitcnt vmcnt(0) lgkmcnt(0)" ::: "memory"); __syncthreads();   \
        if (threadIdx.x == 0) { __builtin_amdgcn_fence(__ATOMIC_RELEASE, "agent"); asm volatile("s_waitcnt vmcnt(0)" ::: "memory"); }   \
        for (int xs_ = 0; xs_ < 1 + XSYNC; ++xs_) grid.sync(); \
        if (threadIdx.x == 0) { __builtin_amdgcn_fence(__ATOMIC_ACQUIRE, "agent"); asm volatile("s_waitcnt vmcnt(0)" ::: "memory"); } __syncthreads(); \
        if (!MK_CG_ONLY) (void)xcd_barrier_post((unsigned*)(WS() + WS_BAR), (volatile LAS unsigned*)(lds + 131072 + 128)); } \
    else { XcdBarrier xb_; xb_.bar = (unsigned*)(WS() + WS_BAR); xb_.x = xb_xcc_id(); xb_.st = (volatile LAS unsigned*)(lds + 131072 + 128); \
        for (int xs_ = 0; xs_ < 1 + XSYNC; ++xs_) xcd_barrier(xb_); } } } while (0)

#if defined(MK_NANFILL) && MK_NANFILL
    if (RUN(ph)) { LT(); unsigned char* ws = WS(); v4u* p = (v4u*)(ws + WS_COS); const size_t n16 = (WS_END - WS_COS) / 16; const v4u q = {0xffffffffu, 0xffffffffu, 0xffffffffu, 0xffffffffu};
        for (size_t i = (size_t)bid * NTHR + tid; i < n16; i += (size_t)G * NTHR) p[i] = q;
        { v4u* z = (v4u*)(ws + WS_MOD); const v4u zz = {0u, 0u, 0u, 0u}; for (size_t i = (size_t)bid * NTHR + tid; i < CTL_ZERO_BYTES / 16; i += (size_t)G * NTHR) z[i] = zz; }
        v4u* o = (v4u*)XO(); for (size_t i = (size_t)bid * NTHR + tid; i < (size_t)M * D / 4; i += (size_t)G * NTHR) o[i] = q; }
    SEAM();
#endif
    if (RUN(ph)) for (int rep_ = 0; rep_ < REP_PRO; ++rep_) { LT(); prologue(a, lds, tid, lane, wave, bid, G); }
    SEAM();
    for (int l = 0; l < DEPTH; ++l) {
        if (RUN(ph)) for (int rep_ = 0; rep_ < REP_NORM; ++rep_) { LT(); unsigned char* ws = WS(); const float* modl = (const float*)(ws + WS_MOD) + (size_t)l * 8 * NMOD;
            norm_mod_phase(l == 0 ? IN(0) : (const float*)XO(), l == 0 ? IN(0) : (const float*)(ws + CH_X0), l == 0 ? (size_t)T * D : (size_t)D, (float*)(ws + CH_H0), IN(2) + l * D, modl, modl + D, (bf16*)(ws + WS_XN), gw, NGW, lane); }
        SEAM();
        if (RUN(ph)) for (int rep_ = 0; rep_ < REP_GEMM_IN; ++rep_) {
            { BG(); unsigned char* ws = WS(); unsigned char* wl = ws + WS_W + (size_t)l * W_LAYER;
              static_assert(W_T2 == W_T1 + (size_t)N1 * D * 2, "the v weight rows continue Wt1");
              pg8::Gemm g{(const bf16*)(ws + WS_XN), (const bf16*)(wl + W_T1), M, NIN, D}; pg8::StaticOrder S; S.init(M, NIN, G, bid);
              pg8::EpiInProj E{(bf16*)(ws + WS_P1), (const float*)(ws + WS_COS), (const float*)(ws + WS_SIN), (const float*)(ws + WS_DQ), (const float*)(ws + WS_DK), (bf16*)(ws + WS_KVT), KVT_LD};
              pg8::gemm_phase<pg8::EpiInProj, pg8::StaticOrder, true, true>(lds, g, S, E); }
            { LT(); unsigned char* ws = WS(); chain_gemv<0, 16>(lds, IN(3) + (size_t)l * D * NIN, D, NIN, (const float*)(ws + CH_H0), (float*)(ws + CH_P0), nullptr, 0, nullptr, bid, G, tid, lane, wave); }
        }
        SEAM();
        if (RUN(ph)) for (int rep_ = 0; rep_ < REP_RET1; ++rep_) { LT(); unsigned char* ws = WS();
            if (wave < 4) ret_scan_phase((const bf16*)(ws + WS_KVT), (bf16*)(ws + WS_ST), (const float*)(ws + WS_DK) + 512, bid, G, wave, lane);
            else conv_phase((const bf16*)(ws + WS_P1), IN(4) + l * 3 * 512, (bf16*)(ws + WS_XN), bid * 4 + (wave - 4), G * 4, lane);
            if (bid == G - 1) chain_mixer((const float*)(ws + CH_P0), IN(4) + l * 3 * 512, IN(5) + l * 512, (float*)(ws + CH_Y0), wave, lane); }
        SEAM();
        if (RUN(ph)) for (int rep_ = 0; rep_ < REP_RET2; ++rep_) { LT(); unsigned char* ws = WS();
            ret_out_phase((const bf16*)(ws + WS_P1), (const bf16*)(ws + WS_KVT), (const bf16*)(ws + WS_ST), IN(5) + l * 512, (bf16*)(ws + WS_XN), lds, bid, G, tid, wave, lane); }
        SEAM();
        if (RUN(ph)) { BG(); unsigned char* ws = WS(); unsigned char* wl = ws + WS_W + (size_t)l * W_LAYER;
            const float* modl = (const float*)(ws + WS_MOD) + (size_t)l * 8 * NMOD;
            pg8::Gemm g{(const bf16*)(ws + WS_XN), (const bf16*)(wl + W_O), M, D, D}; pg8::StaticOrder S; S.init(M, D, G, bid);
            pg8::EpiRes E{l == 0 ? IN(0) : (const float*)XO(), XO(), modl + 2 * D};
            pg8::gemm_phase<pg8::EpiRes, pg8::StaticOrder, true, true>(lds, g, S, E);
            { LT(); unsigned char* ws = WS(); const float* modl = (const float*)(ws + WS_MOD) + (size_t)l * 8 * NMOD;
              chain_gemv<1, 4>(lds, IN(6) + (size_t)l * D * D, D, D, (const float*)(ws + CH_Y0), (float*)(ws + CH_X0), l == 0 ? IN(0) : (const float*)(ws + CH_X0), l == 0 ? (size_t)T * D : (size_t)D, modl + 2 * D, bid, G, tid, lane, wave); } }
        SEAM();
        if (RUN(ph)) for (int rep_ = 0; rep_ < REP_NORM; ++rep_) { LT(); unsigned char* ws = WS(); const float* modl = (const float*)(ws + WS_MOD) + (size_t)l * 8 * NMOD;
            norm_mod_phase(XO(), (const float*)(ws + CH_X0), (size_t)D, (float*)(ws + CH_H0), IN(7) + l * D, modl + 3 * D, modl + 4 * D, (bf16*)(ws + WS_XN), gw, NGW, lane); }
        SEAM();
        if (RUN(ph)) for (int rep_ = 0; rep_ < REP_GEMM_UP; ++rep_) { BG(); unsigned char* ws = WS(); unsigned char* wl = ws + WS_W + (size_t)l * W_LAYER;
            pg8::Gemm g{(const bf16*)(ws + WS_XN), (const bf16*)(wl + W_U), M, FF, D}; pg8::StaticOrder S; S.init(M, FF, G, bid);
            pg8::EpiRelu2 E{(bf16*)(ws + WS_H), FF};
            pg8::gemm_phase<pg8::EpiRelu2, pg8::StaticOrder, true, true>(lds, g, S, E);
            { LT(); unsigned char* ws = WS(); chain_gemv<2, 16>(lds, IN(8) + (size_t)l * D * FF, D, FF, (const float*)(ws + CH_H0), (float*)(ws + CH_U0), nullptr, 0, nullptr, bid, G, tid, lane, wave); } }
        SEAM();
        if (RUN(ph)) { BG(); unsigned char* ws = WS(); unsigned char* wl = ws + WS_W + (size_t)l * W_LAYER;
            const float* modl = (const float*)(ws + WS_MOD) + (size_t)l * 8 * NMOD;
            pg8::Gemm g{(const bf16*)(ws + WS_H), (const bf16*)(wl + W_D), M, D, FF}; pg8::StaticOrder S; S.init(M, D, G, bid);
            pg8::EpiRes E{XO(), XO(), modl + 5 * D};
            pg8::gemm_phase<pg8::EpiRes, pg8::StaticOrder, true, true>(lds, g, S, E);
            { LT(); unsigned char* ws = WS(); const float* modl = (const float*)(ws + WS_MOD) + (size_t)l * 8 * NMOD;
              chain_gemv<1, 4>(lds, IN(9) + (size_t)l * FF * D, FF, D, (const float*)(ws + CH_U0), (float*)(ws + CH_X0), (const float*)(ws + CH_X0), (size_t)D, modl + 5 * D, bid, G, tid, lane, wave); } }
        SEAM();
    }
    if (RUN(ph)) { LT(); final_norm_phase(XO(), (const float*)(WS() + CH_X0), IN(12), gw, NGW, lane); }
#undef RUN
#undef SEAM
}

extern "C" void kernel_launch(void* const* d_in, const int* in_sizes, int n_in, void* d_out, int out_size, void* d_ws, size_t ws_size, hipStream_t stream) {
    static int grid = 0;
    if (grid == 0) {
        if (n_in != 13 || in_sizes[0] != M * D || out_size != M * D || ws_size < WS_END) { fprintf(stderr, "kernel_launch: unexpected shapes (n_in %d, in0 %d, out %d, ws %zu < %zu)\n", n_in, n_in > 0 ? in_sizes[0] : -1, out_size, ws_size, (size_t)WS_END); grid = -1; return; }
        int dev = 0, cus = 0, per_cu = 0;
        hipGetDevice(&dev); hipDeviceGetAttribute(&cus, hipDeviceAttributeMultiprocessorCount, dev);
        if (hipFuncSetAttribute((const void*)fwd_kernel, hipFuncAttributeMaxDynamicSharedMemorySize, LDS_BYTES) != hipSuccess) { fprintf(stderr, "kernel_launch: hipFuncSetAttribute failed\n"); grid = -1; return; }
        if (hipOccupancyMaxActiveBlocksPerMultiprocessor(&per_cu, (const void*)fwd_kernel, NTHR, LDS_BYTES) != hipSuccess || per_cu < 1) { fprintf(stderr, "kernel_launch: occupancy query gives %d\n", per_cu); per_cu = 1; }
        (void)hipGetLastError();
        grid = cus * per_cu;
    }
    if (grid < 0) return;
    Args a{};
    for (int i = 0; i < 13; ++i) a.in[i] = (const float*)d_in[i];
    a.out = (float*)d_out; a.ws = (unsigned char*)d_ws; a.ph_lo = 0; a.ph_hi = 1 << 20;
#if defined(MK_PER_PHASE) && MK_PER_PHASE
    for (int k = 0; k < 2 + MK_NANFILL + 8 * DEPTH; ++k) { a.ph_lo = k; a.ph_hi = k + 1; hipLaunchKernelGGL(fwd_kernel, dim3(grid), dim3(NTHR), LDS_BYTES, stream, a); }
#else
    void* args[] = {&a};
    hipError_t e = hipLaunchCooperativeKernel((const void*)fwd_kernel, dim3(grid), dim3(NTHR), args, LDS_BYTES, stream);
    if (e != hipSuccess) fprintf(stderr, "kernel_launch: cooperative launch failed: %s (grid %d)\n", hipGetErrorString(e), grid);
#endif
}
```

```cpp
#include <hip/hip_runtime.h>
#include <hip/hip_cooperative_groups.h>
#include <cstdio>
#include <cstdint>
namespace cg = cooperative_groups;
namespace pg8 {
#define PG8_LAS __attribute__((address_space(3)))
typedef unsigned short bf16_t;
typedef short bf16x8 __attribute__((ext_vector_type(8)));
typedef float f32x4 __attribute__((ext_vector_type(4)));
typedef unsigned u32x4 __attribute__((ext_vector_type(4)));
constexpr int BM = 256, BK = 64, HALF = 128, HTB = HALF * BK * 2  , STAGE_BYTES = 8 * HTB, NXCD = 8, WGM = 4;

__host__ __device__ __forceinline__ int lds_byte(int r, int c) { const int st = (r >> 4) * 2 + (c >> 5), rr = r & 15, cc = c & 31, ob = rr * 64 + cc * 2; return st * 1024 + (ob ^ (((ob >> 9) & 1) << 5)); }
__host__ __device__ __forceinline__ void stage_rc(int b, int& R, int& C) { const int st = b / 1024, sb = b % 1024, swz = sb ^ (((sb >> 9) & 1) << 5); R = (st >> 1) * 16 + swz / 64; C = (st & 1) * 32 + (swz % 64) / 2; }
__host__ __device__ __forceinline__ int perm32(int rho) { const int n = rho >> 4, i = rho & 15; return 8 * (i >> 2) + 4 * n + (i & 3); }

struct Unit { int pm, pn; };
struct Gemm { const bf16_t* A; const bf16_t* Bt; int M, N, K; };

struct StaticOrder {
    int nM, nN, nwg, G, c;
    __host__ __device__ void init(int M, int N, int G_, int c_) { nM = M / BM; nN = N / BM; nwg = nM * nN; G = G_; c = c_; }
    __host__ __device__ bool next(int i, Unit& u) const {
        const long L = (long)i * G + c; if (L >= nwg) return false;
        int wgid = (int)L; { const int q = nwg / NXCD, r = nwg % NXCD, xcd = wgid % NXCD, off = wgid / NXCD; wgid = (xcd < r ? xcd * (q + 1) : r * (q + 1) + (xcd - r) * q) + off; }
        const int nig = WGM * nN, gid = wgid / nig, fm = gid * WGM, gsz = (nM - fm) < WGM ? (nM - fm) : WGM;
        u.pm = fm + ((wgid % nig) % gsz); u.pn = (wgid % nig) / gsz; return true;
    }
    __device__ __forceinline__ void a_ready(const Unit&) const {}
    __device__ __forceinline__ void done(const Unit&) const {}
};

__device__ __forceinline__ unsigned cvt_pk_bf16(float lo, float hi) { unsigned r; asm volatile("v_cvt_pk_bf16_f32 %0, %1, %2" : "=v"(r) : "v"(lo), "v"(hi)); return r; }
typedef unsigned u32x2 __attribute__((ext_vector_type(2)));
struct EpiInProj {
    static constexpr bool PERM = true, AFTER_DRAIN = false;
    bf16_t* O; const float* cs; const float* sn; const float* dq; const float* dk;
    bf16_t* KT; int ldk;
    __device__ __forceinline__ void operator()(const f32x4 (&acc)[2][2][4][2], const Unit& u, int wr, int wc, int fr, int fq) const {
        const int row0 = u.pm * BM + wr * 64 + fr, col0 = u.pn * BM + wc * 32 + 8 * fq;
        const bool rope = (u.pn >= 6 && u.pn < 10);
        const float* dtab = (u.pn >= 8) ? dk : dq;
        const int hb = (u.pn & 1) * 2;
        if (rope) {
#pragma unroll
            for (int ai = 0; ai < 2; ++ai) {
                f32x4 c4[4], s4[4]; float sc[4][2];
#pragma unroll
                for (int m = 0; m < 4; ++m) { const int row = row0 + ai * HALF + m * 16, t = row & 4095, p = t & 127;
                    c4[m] = *(const f32x4*)(cs + t * 64 + 16 * wc + 4 * fq); s4[m] = *(const f32x4*)(sn + t * 64 + 16 * wc + 4 * fq);
                    sc[m][0] = dtab[hb * 128 + p]; sc[m][1] = dtab[(hb + 1) * 128 + p]; }
                __builtin_amdgcn_sched_barrier(0);
#pragma unroll
                for (int m = 0; m < 4; ++m) { bf16_t* rowp = O + (size_t)(row0 + ai * HALF + m * 16) * 3072 + col0;
#pragma unroll
                    for (int bj = 0; bj < 2; ++bj) {
                        const float s_ = sc[m][bj]; const f32x4 cc = c4[m], ss = s4[m];
                        const f32x4 v0 = acc[ai][bj][m][0], v1 = acc[ai][bj][m][1];
                        u32x4 w;
                        w.x = cvt_pk_bf16((v0[0] * cc[0] - v0[1] * ss[0]) * s_, (v0[0] * ss[0] + v0[1] * cc[0]) * s_);
                        w.y = cvt_pk_bf16((v0[2] * cc[1] - v0[3] * ss[1]) * s_, (v0[2] * ss[1] + v0[3] * cc[1]) * s_);
                        w.z = cvt_pk_bf16((v1[0] * cc[2] - v1[1] * ss[2]) * s_, (v1[0] * ss[2] + v1[1] * cc[2]) * s_);
                        w.w = cvt_pk_bf16((v1[2] * cc[3] - v1[3] * ss[3]) * s_, (v1[2] * ss[3] + v1[3] * cc[3]) * s_);
                        *(u32x4*)(rowp + bj * HALF) = w;
                        if (u.pn >= 8) {
                            const int tokrow = row0 + ai * HALF + m * 16, odd = fr & 1;
                            bf16_t* kt = KT + (size_t)((hb + bj) * 128 + wc * 32 + 8 * fq + odd) * ldk + (tokrow - odd);
#pragma unroll
                            for (int q = 0; q < 4; ++q) { const unsigned mine = w[q], other = (unsigned)__shfl_xor((int)mine, 1);
                                const unsigned pr = odd ? ((other >> 16) | (mine & 0xffff0000u)) : ((mine & 0xffffu) | (other << 16));
                                *(unsigned*)(kt + (size_t)(2 * q) * ldk) = pr; }
                        }
                    } }
                __builtin_amdgcn_sched_barrier(0);
            }
        } else if (u.pn >= 12) {
            const int odd = fr & 1;
#pragma unroll
            for (int ai = 0; ai < 2; ++ai)
#pragma unroll
                for (int m = 0; m < 4; ++m) { const int tokrow = row0 + ai * HALF + m * 16;
#pragma unroll
                    for (int bj = 0; bj < 2; ++bj) {
                        const f32x4 v0 = acc[ai][bj][m][0], v1 = acc[ai][bj][m][1];
                        u32x4 w; w.x = cvt_pk_bf16(v0[0], v0[1]); w.y = cvt_pk_bf16(v0[2], v0[3]); w.z = cvt_pk_bf16(v1[0], v1[1]); w.w = cvt_pk_bf16(v1[2], v1[3]);
                        bf16_t* vt = KT + (size_t)(512 + (u.pn - 12) * BM + bj * HALF + wc * 32 + 8 * fq + odd) * ldk + (tokrow - odd);
#pragma unroll
                        for (int q = 0; q < 4; ++q) { const unsigned mine = w[q], other = (unsigned)__shfl_xor((int)mine, 1);
                            const unsigned pr = odd ? ((other >> 16) | (mine & 0xffff0000u)) : ((mine & 0xffffu) | (other << 16));
                            *(unsigned*)(vt + (size_t)(2 * q) * ldk) = pr; }
                    } }
        } else if (u.pn >= 2 && u.pn < 6) {
            const int c0 = (u.pn - 2) * 128 + wc * 16 + 4 * fq;
#pragma unroll
            for (int ai = 0; ai < 2; ++ai)
#pragma unroll
                for (int m = 0; m < 4; ++m) { bf16_t* rowp = O + (size_t)(row0 + ai * HALF + m * 16) * 3072 + 512 + c0;
#pragma unroll
                    for (int bj = 0; bj < 2; ++bj) {
                        const f32x4 v0 = acc[ai][bj][m][0], v1 = acc[ai][bj][m][1];
                        u32x2 w; w.x = cvt_pk_bf16(v0[0] * v0[1], v0[2] * v0[3]); w.y = cvt_pk_bf16(v1[0] * v1[1], v1[2] * v1[3]);
                        *(u32x2*)(rowp + 64 * bj) = w;
                    } }
        } else {
#pragma unroll
            for (int ai = 0; ai < 2; ++ai)
#pragma unroll
                for (int m = 0; m < 4; ++m) { bf16_t* rowp = O + (size_t)(row0 + ai * HALF + m * 16) * 3072 + col0;
#pragma unroll
                    for (int bj = 0; bj < 2; ++bj) {
                        const f32x4 v0 = acc[ai][bj][m][0], v1 = acc[ai][bj][m][1];
                        u32x4 w; w.x = cvt_pk_bf16(v0[0], v0[1]); w.y = cvt_pk_bf16(v0[2], v0[3]); w.z = cvt_pk_bf16(v1[0], v1[1]); w.w = cvt_pk_bf16(v1[2], v1[3]);
                        *(u32x4*)(rowp + bj * HALF) = w;
                    } }
        }
    }
};
struct EpiKVT {
    static constexpr bool PERM = true, AFTER_DRAIN = false;
    bf16_t* O; const float* csT; const float* snT; const float* dk; int ldo;
    __device__ __forceinline__ void operator()(const f32x4 (&acc)[2][2][4][2], const Unit& u, int wr, int wc, int fr, int fq) const {
        const int col0 = u.pn * BM + wc * 32 + 8 * fq;
        if (u.pm < 2) {
#pragma unroll
            for (int bj = 0; bj < 2; ++bj) {
                const int tok = col0 + bj * HALF, t = tok & 4095;
                f32x4 c4[2][2], s4[2][2], d4[2][2];
#pragma unroll
                for (int mm = 0; mm < 2; ++mm)
#pragma unroll
                    for (int n = 0; n < 2; ++n) { const int i = 32 * wr + 16 * mm + fr;
                        c4[mm][n] = *(const f32x4*)(csT + i * (4096 + 32) + t + 4 * n); s4[mm][n] = *(const f32x4*)(snT + i * (4096 + 32) + t + 4 * n);
                        d4[mm][n] = *(const f32x4*)(dk + (2 * u.pm + mm) * 128 + (t & 127) + 4 * n); }
                __builtin_amdgcn_sched_barrier(0);
#pragma unroll
                for (int ai = 0; ai < 2; ++ai)
#pragma unroll
                    for (int mm = 0; mm < 2; ++mm) {
                        const int i = 32 * wr + 16 * mm + fr;
                        bf16_t* r1 = O + (size_t)((2 * u.pm + ai) * 128 + 2 * i) * ldo; bf16_t* r2 = r1 + ldo;
                        u32x4 w1, w2;
#pragma unroll
                        for (int n = 0; n < 2; ++n) {
                            const f32x4 cc = c4[mm][n], ss = s4[mm][n], dd = d4[ai][n];
                            const f32x4 x1 = acc[ai][bj][mm][n], x2 = acc[ai][bj][mm + 2][n];
                            const f32x4 o1 = (x1 * cc - x2 * ss) * dd, o2 = (x1 * ss + x2 * cc) * dd;
                            if (n == 0) { w1.x = cvt_pk_bf16(o1[0], o1[1]); w1.y = cvt_pk_bf16(o1[2], o1[3]); w2.x = cvt_pk_bf16(o2[0], o2[1]); w2.y = cvt_pk_bf16(o2[2], o2[3]); }
                            else        { w1.z = cvt_pk_bf16(o1[0], o1[1]); w1.w = cvt_pk_bf16(o1[2], o1[3]); w2.z = cvt_pk_bf16(o2[0], o2[1]); w2.w = cvt_pk_bf16(o2[2], o2[3]); }
                        }
                        *(u32x4*)(r1 + tok) = w1; *(u32x4*)(r2 + tok) = w2;
                    }
                __builtin_amdgcn_sched_barrier(0);
            }
        } else {
#pragma unroll
            for (int ai = 0; ai < 2; ++ai)
#pragma unroll
                for (int m = 0; m < 4; ++m) {
                    bf16_t* rowp = O + (size_t)(u.pm * BM + ai * HALF + wr * 64 + m * 16 + fr) * ldo + col0;
#pragma unroll
                    for (int bj = 0; bj < 2; ++bj) {
                        const f32x4 v0 = acc[ai][bj][m][0], v1 = acc[ai][bj][m][1];
                        u32x4 w; w.x = cvt_pk_bf16(v0[0], v0[1]); w.y = cvt_pk_bf16(v0[2], v0[3]); w.z = cvt_pk_bf16(v1[0], v1[1]); w.w = cvt_pk_bf16(v1[2], v1[3]);
                        *(u32x4*)(rowp + bj * HALF) = w;
                    }
                }
        }
    }
};
struct EpiVT {
    static constexpr bool PERM = true, AFTER_DRAIN = false;
    bf16_t* O; int ldo;
    __device__ __forceinline__ void operator()(const f32x4 (&acc)[2][2][4][2], const Unit& u, int wr, int wc, int fr, int fq) const {
        const int col0 = u.pn * BM + wc * 32 + 8 * fq;
#pragma unroll
        for (int ai = 0; ai < 2; ++ai)
#pragma unroll
            for (int m = 0; m < 4; ++m) {
                bf16_t* rowp = O + (size_t)(u.pm * BM + ai * HALF + wr * 64 + m * 16 + fr) * ldo + col0;
#pragma unroll
                for (int bj = 0; bj < 2; ++bj) {
                    const f32x4 v0 = acc[ai][bj][m][0], v1 = acc[ai][bj][m][1];
                    u32x4 w; w.x = cvt_pk_bf16(v0[0], v0[1]); w.y = cvt_pk_bf16(v0[2], v0[3]); w.z = cvt_pk_bf16(v1[0], v1[1]); w.w = cvt_pk_bf16(v1[2], v1[3]);
                    *(u32x4*)(rowp + bj * HALF) = w;
                }
            }
    }
};
struct EpiRes {
    static constexpr bool PERM = false, AFTER_DRAIN = false;
    const float* base; float* out; const float* gate;
    __device__ __forceinline__ void operator()(const f32x4 (&acc)[2][2][4][2], const Unit& u, int wr, int wc, int fr, int fq) const {
        const int b = u.pm >> 4, col0 = u.pn * BM + wc * 32 + 4 * fq, row0 = u.pm * BM + wr * 64 + fr;
        f32x4 g[2][2];
#pragma unroll
        for (int bj = 0; bj < 2; ++bj)
#pragma unroll
            for (int n = 0; n < 2; ++n) g[bj][n] = *(const f32x4*)(gate + b * 6144 + col0 + bj * HALF + n * 16);
#pragma unroll
        for (int ai = 0; ai < 2; ++ai) {
            f32x4 bs[4][2][2];
#pragma unroll
            for (int m = 0; m < 4; ++m) { const size_t off = (size_t)(row0 + ai * HALF + m * 16) * 1024 + col0;
#pragma unroll
                for (int bj = 0; bj < 2; ++bj)
#pragma unroll
                    for (int n = 0; n < 2; ++n) bs[m][bj][n] = *(const f32x4*)(base + off + bj * HALF + n * 16); }
            __builtin_amdgcn_sched_barrier(0);
#pragma unroll
            for (int m = 0; m < 4; ++m) { const size_t off = (size_t)(row0 + ai * HALF + m * 16) * 1024 + col0;
#pragma unroll
                for (int bj = 0; bj < 2; ++bj)
#pragma unroll
                    for (int n = 0; n < 2; ++n) *(f32x4*)(out + off + bj * HALF + n * 16) = bs[m][bj][n] + g[bj][n] * acc[ai][bj][m][n]; }
            __builtin_amdgcn_sched_barrier(0);
        }
    }
};
struct EpiRelu2 {
    static constexpr bool PERM = true, AFTER_DRAIN = false;
    bf16_t* O; int ldc;
    __device__ __forceinline__ void operator()(const f32x4 (&acc)[2][2][4][2], const Unit& u, int wr, int wc, int fr, int fq) const {
        const int row0 = u.pm * BM + wr * 64 + fr, col0 = u.pn * BM + wc * 32 + 8 * fq;
#pragma unroll
        for (int ai = 0; ai < 2; ++ai)
#pragma unroll
            for (int m = 0; m < 4; ++m) {
                bf16_t* rowp = O + (size_t)(row0 + ai * HALF + m * 16) * ldc + col0;
#pragma unroll
                for (int bj = 0; bj < 2; ++bj) {
                    f32x4 v0 = acc[ai][bj][m][0], v1 = acc[ai][bj][m][1];
                    v0 = __builtin_elementwise_max(v0, (f32x4){0.f, 0.f, 0.f, 0.f}); v1 = __builtin_elementwise_max(v1, (f32x4){0.f, 0.f, 0.f, 0.f});
                    v0 = v0 * v0; v1 = v1 * v1;
                    u32x4 w; w.x = cvt_pk_bf16(v0[0], v0[1]); w.y = cvt_pk_bf16(v0[2], v0[3]); w.z = cvt_pk_bf16(v1[0], v1[1]); w.w = cvt_pk_bf16(v1[2], v1[3]);
                    __builtin_nontemporal_store(w, (u32x4*)(rowp + bj * HALF));
                }
            }
    }
};
template <class Epi, class Sched, bool ALIGN_EPI = false, bool SP2 = false>
__device__ __forceinline__ void gemm_phase(PG8_LAS unsigned char* lds, const Gemm g, const Sched& S, const Epi& E) {
    int tid = threadIdx.x; asm volatile("" : "+v"(tid));
    const int wid = __builtin_amdgcn_readfirstlane(tid >> 6), lane = tid & 63, wr = wid >> 2, wc = wid & 3, fr = lane & 15, fq = lane >> 4;
    const int K = g.K, nt = K / BK;
    unsigned voffA[2], voffB[2];
#pragma unroll
    for (int i = 0; i < 2; ++i) { int R, C; stage_rc(tid * 16 + i * 8192, R, C); const int Rb = Epi::PERM ? ((R & ~31) + perm32(R & 31)) : R;
        voffA[i] = (unsigned)(R * K + C) * 2u; voffB[i] = (unsigned)(Rb * K + C) * 2u; }
    const size_t kstep = (size_t)(BK * 2);
    const size_t hstep = (size_t)HALF * K * 2;
    const size_t tstep = 2 * hstep;
    const unsigned ldsw = (unsigned)wid * 1024u;
    const int aoff = lds_byte(wr * 64 + fr, fq * 8), boff = lds_byte(wc * 32 + fr, fq * 8);
#define PG8_SA(b, h) (((b) * 2 + (h)) * HTB)
#define PG8_SB(b, h) ((4 + (b) * 2 + (h)) * HTB)
#define PG8_STAGE(bufoff, gbase, voff) do { _Pragma("unroll") for (int _i = 0; _i < 2; ++_i) \
        __builtin_amdgcn_global_load_lds((const unsigned*)((const char*)(gbase) + (voff)[_i]), (PG8_LAS unsigned*)(lds + (bufoff) + ldsw + _i * 8192), 16, 0, 0); } while (0)
#define PG8_LDA(dst, b, h) do { _Pragma("unroll") for (int m = 0; m < 4; ++m) _Pragma("unroll") for (int k = 0; k < 2; ++k) dst[m][k] = *(const PG8_LAS bf16x8*)(lds + PG8_SA(b, h) + aoff + m * 2048 + k * 1024); } while (0)
#define PG8_LDB(dst, b, h) do { _Pragma("unroll") for (int n = 0; n < 2; ++n) _Pragma("unroll") for (int k = 0; k < 2; ++k) dst[n][k] = *(const PG8_LAS bf16x8*)(lds + PG8_SB(b, h) + boff + n * 2048 + k * 1024); } while (0)
#define PG8_MMA(ai, bj, At, Bt) do { __builtin_amdgcn_s_setprio(1); _Pragma("unroll") for (int m = 0; m < 4; ++m) _Pragma("unroll") for (int n = 0; n < 2; ++n) _Pragma("unroll") for (int k = 0; k < 2; ++k) \
        acc[ai][bj][m][n] = __builtin_amdgcn_mfma_f32_16x16x32_bf16(Bt[n][k], At[m][k], acc[ai][bj][m][n], 0, 0, 0); __builtin_amdgcn_s_setprio(0); } while (0)
#define PG8_WAIT_V(n) asm volatile("s_waitcnt vmcnt(" #n ")" ::: "memory")
#define PG8_WAIT_L(n) asm volatile("s_waitcnt lgkmcnt(" #n ")" ::: "memory")
#define PG8_BAR __builtin_amdgcn_s_barrier()
#define PG8_SCHED __builtin_amdgcn_sched_barrier(0)
    Unit cur, nxt; int ui = 0;
    if (!S.next(0, cur)) return;
    f32x4 acc[2][2][4][2];
#pragma unroll
    for (int a = 0; a < 2; ++a)
#pragma unroll
        for (int b = 0; b < 2; ++b)
#pragma unroll
            for (int m = 0; m < 4; ++m)
#pragma unroll
                for (int n = 0; n < 2; ++n) acc[a][b][m][n] = (f32x4){0.f, 0.f, 0.f, 0.f};
    bf16x8 At[4][2], B0[2][2], B1[2][2];
    const char* cA = (const char*)g.A + (size_t)cur.pm * tstep; const char* cB = (const char*)g.Bt + (size_t)cur.pn * tstep;
    S.a_ready(cur);
    if constexpr (SP2) {
        PG8_STAGE(PG8_SB(0, 0), cB, voffB); PG8_STAGE(PG8_SB(0, 1), cB + hstep, voffB); PG8_STAGE(PG8_SA(0, 0), cA, voffA); PG8_STAGE(PG8_SA(0, 1), cA + hstep, voffA);
        if (wr == 1) PG8_BAR;
        PG8_WAIT_V(2); PG8_BAR;
        PG8_STAGE(PG8_SB(1, 0), cB + kstep, voffB); PG8_STAGE(PG8_SA(1, 0), cA + kstep, voffA); PG8_STAGE(PG8_SB(1, 1), cB + hstep + kstep, voffB);
        PG8_WAIT_V(6); PG8_BAR;
    } else {
        PG8_STAGE(PG8_SB(0, 0), cB, voffB); PG8_STAGE(PG8_SA(0, 0), cA, voffA); PG8_STAGE(PG8_SB(0, 1), cB + hstep, voffB); PG8_STAGE(PG8_SA(0, 1), cA + hstep, voffA);
        if (wr == 1) PG8_BAR;
        PG8_WAIT_V(4); PG8_BAR;
        PG8_STAGE(PG8_SB(1, 0), cB + kstep, voffB); PG8_STAGE(PG8_SA(1, 0), cA + kstep, voffA); PG8_STAGE(PG8_SB(1, 1), cB + hstep + kstep, voffB);
        PG8_WAIT_V(6); PG8_BAR;
    }
    for (;;) {
        const bool has_next = S.next(ui + 1, nxt);
        const char* nA = has_next ? (const char*)g.A + (size_t)nxt.pm * tstep : cA; const char* nB = has_next ? (const char*)g.Bt + (size_t)nxt.pn * tstep : cB;
        for (int t = 0; t < nt; t += 2) {
            const bool last = (t == nt - 2);
            const char* a1 = cA + (size_t)(t + 1) * kstep;
            const char* a2 = last ? nA : cA + (size_t)(t + 2) * kstep; const char* b2 = last ? nB : cB + (size_t)(t + 2) * kstep;
            const char* a3 = a2 + kstep; const char* b3 = b2 + kstep;
            if (last && has_next) S.a_ready(nxt);
            if constexpr (SP2) {
            PG8_LDB(B0, 0, 0); PG8_LDB(B1, 0, 1); PG8_SCHED; PG8_LDA(At, 0, 0); PG8_STAGE(PG8_SA(1, 1), a1 + hstep, voffA);
            PG8_WAIT_V(8); PG8_WAIT_L(0); PG8_BAR; PG8_MMA(0, 0, At, B0); PG8_MMA(0, 1, At, B1); PG8_BAR; PG8_SCHED;
            PG8_LDA(At, 0, 1); PG8_STAGE(PG8_SB(0, 0), b2, voffB); PG8_STAGE(PG8_SB(0, 1), b2 + hstep, voffB); PG8_STAGE(PG8_SA(0, 0), a2, voffA);
            PG8_WAIT_V(8); PG8_WAIT_L(0); PG8_BAR; PG8_MMA(1, 0, At, B0); PG8_MMA(1, 1, At, B1); PG8_BAR; PG8_SCHED;
            PG8_LDB(B0, 1, 0); PG8_LDB(B1, 1, 1); PG8_SCHED; PG8_LDA(At, 1, 0); PG8_STAGE(PG8_SA(0, 1), a2 + hstep, voffA);
            PG8_WAIT_V(8); PG8_WAIT_L(0); PG8_BAR; PG8_MMA(0, 0, At, B0); PG8_MMA(0, 1, At, B1); PG8_BAR; PG8_SCHED;
            PG8_LDA(At, 1, 1); PG8_STAGE(PG8_SB(1, 0), b3, voffB); PG8_STAGE(PG8_SB(1, 1), b3 + hstep, voffB); PG8_STAGE(PG8_SA(1, 0), a3, voffA);
            PG8_WAIT_V(8); PG8_WAIT_L(0); PG8_BAR; PG8_MMA(1, 0, At, B0); PG8_MMA(1, 1, At, B1); PG8_BAR; PG8_SCHED;
            } else {
            PG8_LDB(B0, 0, 0); PG8_SCHED; PG8_LDA(At, 0, 0); PG8_STAGE(PG8_SA(1, 1), a1 + hstep, voffA);
            PG8_WAIT_L(8); PG8_BAR; PG8_WAIT_L(0); PG8_MMA(0, 0, At, B0); PG8_BAR; PG8_SCHED;
            PG8_LDB(B1, 0, 1); PG8_STAGE(PG8_SB(0, 0), b2, voffB);
            PG8_BAR; PG8_WAIT_L(0); PG8_MMA(0, 1, At, B1); PG8_BAR;
            PG8_LDA(At, 0, 1); PG8_STAGE(PG8_SA(0, 0), a2, voffA);
            PG8_BAR; PG8_WAIT_L(0); PG8_MMA(1, 0, At, B0); PG8_BAR; PG8_SCHED;
            PG8_STAGE(PG8_SB(0, 1), b2 + hstep, voffB);
            PG8_WAIT_V(6); PG8_BAR; PG8_MMA(1, 1, At, B1); PG8_BAR;
            PG8_LDB(B0, 1, 0); PG8_SCHED; PG8_LDA(At, 1, 0); PG8_STAGE(PG8_SA(0, 1), a2 + hstep, voffA);
            PG8_WAIT_L(8); PG8_BAR; PG8_WAIT_L(0); PG8_MMA(0, 0, At, B0); PG8_BAR; PG8_SCHED;
            PG8_LDB(B1, 1, 1); PG8_STAGE(PG8_SB(1, 0), b3, voffB);
            PG8_BAR; PG8_WAIT_L(0); PG8_MMA(0, 1, At, B1); PG8_BAR;
            PG8_LDA(At, 1, 1); PG8_STAGE(PG8_SA(1, 0), a3, voffA);
            PG8_BAR; PG8_WAIT_L(0); PG8_MMA(1, 0, At, B0); PG8_BAR; PG8_SCHED;
            PG8_STAGE(PG8_SB(1, 1), b3 + hstep, voffB);
            PG8_WAIT_V(6); PG8_BAR; PG8_MMA(1, 1, At, B1); PG8_BAR;
            }
        }
        if constexpr (ALIGN_EPI) { if (wr == 0) PG8_BAR; }
        if constexpr (!Epi::AFTER_DRAIN) { E(acc, cur, wr, wc, fr, fq); S.done(cur); }
        if (!has_next) break;
#pragma unroll
        for (int a = 0; a < 2; ++a)
#pragma unroll
            for (int b = 0; b < 2; ++b)
#pragma unroll
                for (int m = 0; m < 4; ++m)
#pragma unroll
                    for (int n = 0; n < 2; ++n) acc[a][b][m][n] = (f32x4){0.f, 0.f, 0.f, 0.f};
        cur = nxt; cA = nA; cB = nB; ++ui;
        if constexpr (ALIGN_EPI) { if (wr == 1) PG8_BAR; }
    }
    PG8_WAIT_V(0);
    if constexpr (!ALIGN_EPI) { if (wr == 0) PG8_BAR; }
    PG8_BAR;
    if constexpr (Epi::AFTER_DRAIN) { E.fused(acc, cur, wr, wc, fr, fq, lds, wid, lane); S.done(cur); }
#undef PG8_SA
#undef PG8_SB
#undef PG8_STAGE
#undef PG8_LDA
#undef PG8_LDB
#undef PG8_MMA
#undef PG8_WAIT_V
#undef PG8_WAIT_L
#undef PG8_BAR
#undef PG8_SCHED
}
}
#define LAS __attribute__((address_space(3)))
typedef unsigned short bf16;
typedef unsigned v4u __attribute__((ext_vector_type(4)));
typedef unsigned v2u __attribute__((ext_vector_type(2)));
typedef float f32x4 __attribute__((ext_vector_type(4)));
typedef short bf16x8 __attribute__((ext_vector_type(8)));

constexpr int NWAVES = 8, NTHR = NWAVES * 64;
constexpr int BATCH = 8, T = 4096, D = 1024, DEPTH = 4, M = BATCH * T;
constexpr int NHEAD = 4, HD = 128, NCH = T / 128, FF = 4096, NIN = 3584, NMOD = 6 * D;
constexpr int N1 = 3072, N2 = 1024;
constexpr float EPS = 1e-6f;
constexpr size_t MiB = 1u << 20;
constexpr size_t WS_MOD = 0, CTL_ZERO_BYTES = 1 * MiB;
constexpr size_t WS_BAR = 800 * 1024;
constexpr int KVT_LD = M + 2048 + 64, CST_LD = T + 32;
constexpr size_t WS_COS = 1 * MiB, WS_SIN = 2 * MiB, WS_COST = 3 * MiB, WS_SINT = 4 * MiB + 256 * 1024, WS_DQ = 5 * MiB + 512 * 1024, WS_DK = WS_DQ + 4096;
constexpr size_t WS_W = 6 * MiB;
constexpr size_t W_LAYER = 26 * MiB, W_T1 = 0, W_T2 = 6 * MiB, W_O = 8 * MiB, W_U = 10 * MiB, W_D = 18 * MiB;
constexpr size_t WS_XN = WS_W + DEPTH * W_LAYER;
constexpr size_t WS_P1 = WS_XN + 64 * MiB;
constexpr size_t WS_KVT = WS_P1 + 192 * MiB;
constexpr size_t WS_H = WS_P1;
constexpr size_t WS_ST = WS_KVT + 69 * MiB;
constexpr size_t WS_END = WS_ST + 32 * MiB;
constexpr size_t WS_CH = WS_DQ + 65536, CH_X0 = WS_CH, CH_H0 = WS_CH + 32768, CH_P0 = WS_CH + 65536, CH_Y0 = CH_P0 + 8 * 3584 * 4, CH_U0 = CH_Y0 + 32768;
static_assert(CH_U0 + 8 * 4096 * 4 <= 6 * MiB, "chain buffers");
constexpr int LDS_BYTES = 147456;
#ifndef REP_PRO
#define REP_PRO 1
#endif
#ifndef REP_PRO_T
#define REP_PRO_T 1
#endif
#ifndef REP_NORM
#define REP_NORM 1
#endif
#ifndef REP_GEMM_IN
#define REP_GEMM_IN 1
#endif
#ifndef REP_GEMM_UP
#define REP_GEMM_UP 1
#endif
#ifndef REP_RET1
#define REP_RET1 1
#endif
#ifndef REP_RET2
#define REP_RET2 1
#endif
#ifndef XSYNC
#define XSYNC 0
#endif
#ifndef MK_CG_ONLY
#define MK_CG_ONLY 0
#endif
#ifndef MK_NANFILL
#define MK_NANFILL 0
#endif
#ifndef MK_PER_PHASE
#define MK_PER_PHASE 0
#endif

__device__ __forceinline__ unsigned f2bf(float f) { unsigned u = __builtin_bit_cast(unsigned, f); return (u + 0x7fffu + ((u >> 16) & 1u)) >> 16; }
__device__ __forceinline__ unsigned pk2(float lo, float hi) { return f2bf(lo) | (f2bf(hi) << 16); }
__device__ __forceinline__ float bf2f(unsigned short h) { return __builtin_bit_cast(float, (unsigned)h << 16); }
__device__ __forceinline__ float bflo(unsigned w) { return __builtin_bit_cast(float, w << 16); }
__device__ __forceinline__ float bfhi(unsigned w) { return __builtin_bit_cast(float, w & 0xffff0000u); }
#define LDS_WAIT() asm volatile("s_waitcnt lgkmcnt(0)" ::: "memory")
__device__ __forceinline__ float wave_sum(float v) {
#pragma unroll
    for (int o = 1; o < 64; o <<= 1) v += __shfl_xor(v, o);
    return v;
}

__device__ __forceinline__ void tr_load(const float* W, int N, int k0, int n0, LAS float* scr, int lane) {
    float tv[32];
#pragma unroll
    for (int i = 0; i < 32; ++i) tv[i] = W[(size_t)(k0 + 2 * i + (lane >> 5)) * N + n0 + (lane & 31)];
#pragma unroll
    for (int i = 0; i < 32; ++i) scr[(2 * i + (lane >> 5)) * 33 + (lane & 31)] = tv[i];
    LDS_WAIT(); asm volatile("" ::: "memory");
}
__device__ __forceinline__ void win_rows(int c, int& r1, int& r2) {
    const int seg = c >> 9, j = c & 511, head = j >> 7, d = j & 127, i = d & 63, half = d >> 6;
    const int permQ = 2 * i + half, permT = 64 * (i >> 5) + 32 * half + (i & 31);
    r1 = -1; r2 = -1;
    if (seg == 0) r1 = c;
    else if (seg < 3) r1 = 512 + 2 * j + (seg - 1);
    else if (seg == 3) r1 = 1536 + head * 128 + permQ;
    else if (seg == 4) { r1 = 2048 + head * 128 + permQ; (void)permT; }
    else if (seg == 5) r2 = j;
    else r1 = 2560 + j;
}
__device__ __forceinline__ void tr_store_plain(bf16* WT, int K, int k0, int n0, const LAS float* scr, int lane) {
    const int c = lane & 7;
#pragma unroll
    for (int j = 0; j < 4; ++j) { const int n = (lane >> 3) + 8 * j; const LAS float* s = scr + (8 * c) * 33 + n;
        v4u o; o.x = pk2(s[0 * 33], s[1 * 33]); o.y = pk2(s[2 * 33], s[3 * 33]); o.z = pk2(s[4 * 33], s[5 * 33]); o.w = pk2(s[6 * 33], s[7 * 33]);
        *(v4u*)(WT + (size_t)(n0 + n) * K + k0 + 8 * c) = o; }
}
__device__ __forceinline__ void tr_store_win(bf16* Wt1, bf16* Wt2, int k0, int n0, const LAS float* scr, int lane) {
    const int c = lane & 7;
#pragma unroll
    for (int j = 0; j < 4; ++j) { const int n = (lane >> 3) + 8 * j; const LAS float* s = scr + (8 * c) * 33 + n;
        v4u o; o.x = pk2(s[0 * 33], s[1 * 33]); o.y = pk2(s[2 * 33], s[3 * 33]); o.z = pk2(s[4 * 33], s[5 * 33]); o.w = pk2(s[6 * 33], s[7 * 33]);
        int r1, r2; win_rows(n0 + n, r1, r2);
        if (r1 >= 0) *(v4u*)(Wt1 + (size_t)r1 * D + k0 + 8 * c) = o;
        if (r2 >= 0) *(v4u*)(Wt2 + (size_t)r2 * D + k0 + 8 * c) = o; }
}

struct Args { const float* in[13]; float* out; unsigned char* ws; int ph_lo, ph_hi; };

__device__ __forceinline__ void prologue(const Args& a, LAS unsigned char* lds, int tid, int lane, int wave, int bid, int G) {
    unsigned char* ws = a.ws;
    const int gw = bid * NWAVES + wave, NGW = G * NWAVES, gt = bid * NTHR + tid, NGT = G * NTHR;
    {
        float* cs = (float*)(ws + WS_COS); float* sn = (float*)(ws + WS_SIN);
        LAS float* invf = (LAS float*)(lds + 131072 + 256);
        if (tid < 64) invf[tid] = (float)pow(10000.0, -(double)(2 * tid) / 128.0);
        __syncthreads();
        for (int e = gt; e < T * 64; e += NGT) {
            const int t = e >> 6, i = e & 63;
            const double ang = (double)((float)t * invf[i]);
            const double q = __builtin_rint(ang * 0.15915494309189535);
            const float r = (float)(ang - q * 6.283185307179586);
            const float c = cosf(r), s = sinf(r);
            cs[e] = c; sn[e] = s;
        }
        if (bid == 0) {
            float* dq = (float*)(ws + WS_DQ); float* dk = (float*)(ws + WS_DK);
            const int h = tid >> 7, p = tid & 127;
            const double lg = log1p(-exp2(-5.0 - (double)h));
            dq[tid] = (float)exp(lg * (double)(p + 1));
            dk[tid] = (float)(exp(-lg * (double)(p + 1)) * 0.08838834764831845);
            if (p == 0) dk[512 + h] = (float)exp(128.0 * lg);
        }
    }
    {
        LAS float* cact = (LAS float*)(lds + 98304);
        const float* c = a.in[1];
        for (int e = tid; e < BATCH * D; e += NTHR) { const float v = c[e]; cact[e] = v / (1.f + __expf(-v)); }
        __syncthreads();
        float* mod = (float*)(ws + WS_MOD); const float* w_ada = a.in[10]; const float* b_ada = a.in[11];
        LAS float* red = (LAS float*)(lds + 131072 + 256);
        const int col = lane & 31, kh = lane >> 5, k0 = wave * 128;
        for (int it = bid; it < DEPTH * (NMOD / 32); it += G) {
            const int cb = it % (NMOD / 32), l = it / (NMOD / 32);
            const float* W = w_ada + (size_t)l * D * NMOD + (size_t)(k0 + kh) * NMOD + cb * 32 + col;
            float acc[8];
#pragma unroll
            for (int b = 0; b < 8; ++b) acc[b] = 0.f;
            for (int j0 = 0; j0 < 64; j0 += 32) {
                float wv[32];
#pragma unroll
                for (int j = 0; j < 32; ++j) wv[j] = W[(size_t)(2 * (j0 + j)) * NMOD];
#pragma unroll
                for (int j = 0; j < 32; ++j)
#pragma unroll
                    for (int b = 0; b < 8; ++b) acc[b] += cact[b * D + k0 + 2 * (j0 + j) + kh] * wv[j];
            }
#pragma unroll
            for (int b = 0; b < 8; ++b) acc[b] += __shfl_xor(acc[b], 32);
            if (kh == 0) {
#pragma unroll
                for (int b = 0; b < 8; ++b) red[(wave * 8 + b) * 32 + col] = acc[b]; }
            __syncthreads();
            if (tid < 256) { const int b = tid >> 5, c = tid & 31; float s_ = 0.f;
#pragma unroll
                for (int w = 0; w < 8; ++w) s_ += red[(w * 8 + b) * 32 + c];
                mod[((size_t)l * 8 + b) * NMOD + cb * 32 + c] = s_ + b_ada[l * NMOD + cb * 32 + c]; }
            __syncthreads();
        }
    }
    for (int rt_ = 0; rt_ < REP_PRO_T; ++rt_) {
        LAS float* scr = (LAS float*)(lds + wave * 8448);
        constexpr int I_IN = 16 * 112, I_O = 16 * 32, I_U = 16 * 128, I_D = 64 * 32, I_L = I_IN + I_O + I_U + I_D;
        for (int it = gw; it < DEPTH * I_L; it += NGW) {
            const int l = it / I_L; int r = it % I_L;
            unsigned char* wl = ws + WS_W + (size_t)l * W_LAYER;
            if (r < I_IN) { const int kb = r / 112, nb = r % 112; tr_load(a.in[3] + (size_t)l * D * NIN, NIN, 64 * kb, 32 * nb, scr, lane);
                tr_store_win((bf16*)(wl + W_T1), (bf16*)(wl + W_T2), 64 * kb, 32 * nb, scr, lane); LDS_WAIT(); asm volatile("" ::: "memory"); continue; } r -= I_IN;
            if (r < I_O) { const int kb = r / 32, nb = r % 32; tr_load(a.in[6] + (size_t)l * D * D, D, 64 * kb, 32 * nb, scr, lane);
                tr_store_plain((bf16*)(wl + W_O), D, 64 * kb, 32 * nb, scr, lane); LDS_WAIT(); asm volatile("" ::: "memory"); continue; } r -= I_O;
            if (r < I_U) { const int kb = r / 128, nb = r % 128; tr_load(a.in[8] + (size_t)l * D * FF, FF, 64 * kb, 32 * nb, scr, lane);
                tr_store_plain((bf16*)(wl + W_U), D, 64 * kb, 32 * nb, scr, lane); LDS_WAIT(); asm volatile("" ::: "memory"); continue; } r -= I_U;
            { const int kb = r / 32, nb = r % 32; tr_load(a.in[9] + (size_t)l * FF * D, D, 64 * kb, 32 * nb, scr, lane);
                tr_store_plain((bf16*)(wl + W_D), FF, 64 * kb, 32 * nb, scr, lane); LDS_WAIT(); asm volatile("" ::: "memory"); }
        }
    }
}

__device__ __forceinline__ void norm_mod_phase(const float* x, const float* x0src, size_t x0stride, float* h0buf, const float* g, const float* sh, const float* sc, bf16* XN, int gw, int NGW, int lane) {
    const int wpb = NGW / BATCH, rpw = T / wpb;
    const int b = gw / wpb, wi = gw - b * wpb;
    f32x4 gm[4], s0[4];
#pragma unroll
    for (int j = 0; j < 4; ++j) { const int col = 4 * lane + 256 * j; gm[j] = *(const f32x4*)(g + col) * (*(const f32x4*)(sc + b * NMOD + col) + 1.f); s0[j] = *(const f32x4*)(sh + b * NMOD + col); }
    for (int k = 0; k < rpw; k += 4) {
        f32x4 v[4][4];
#pragma unroll
        for (int r = 0; r < 4; ++r) { const int t = wi + wpb * (k + r); const bool t0 = t == 0;
            const f32x4* xr = (const f32x4*)(t0 ? x0src + (size_t)b * x0stride : x + ((size_t)b * T + t) * D) + lane;
#pragma unroll
            for (int j = 0; j < 4; ++j) v[r][j] = xr[64 * j]; }
        __builtin_amdgcn_sched_barrier(0);
#pragma unroll
        for (int r = 0; r < 4; ++r) { const int t = wi + wpb * (k + r); const bool t0 = t == 0; const size_t row = (size_t)b * T + t;
            float ss = 0.f;
#pragma unroll
            for (int j = 0; j < 4; ++j) ss += (v[r][j].x * v[r][j].x + v[r][j].y * v[r][j].y) + (v[r][j].z * v[r][j].z + v[r][j].w * v[r][j].w);
            const float rstd = 1.f / sqrtf(wave_sum(ss) * (1.f / D) + EPS);
#pragma unroll
            for (int j = 0; j < 4; ++j) { const int col = 4 * lane + 256 * j;
                const f32x4 h = v[r][j] * rstd * gm[j] + s0[j];
                v2u o; o.x = pk2(h.x, h.y); o.y = pk2(h.z, h.w);
                *(v2u*)(XN + row * D + col) = o;
                if (t0) *(f32x4*)(h0buf + b * D + col) = h; } }
    }
}
__device__ __forceinline__ void final_norm_phase(float* x, const float* x0buf, const float* g, int gw, int NGW, int lane) {
    f32x4 gg[4];
#pragma unroll
    for (int j = 0; j < 4; ++j) gg[j] = *(const f32x4*)(g + 4 * lane + 256 * j);
    for (int row0 = gw; row0 < M; row0 += 4 * NGW) {
        f32x4 v[4][4];
#pragma unroll
        for (int r = 0; r < 4; ++r) { const int row = row0 + r * NGW; const bool t0 = (row & 4095) == 0;
            const f32x4* xs = t0 ? (const f32x4*)(x0buf + (size_t)(row >> 12) * D) + lane : (const f32x4*)(x + (size_t)row * D) + lane;
#pragma unroll
            for (int j = 0; j < 4; ++j) v[r][j] = xs[64 * j]; }
        __builtin_amdgcn_sched_barrier(0);
#pragma unroll
        for (int r = 0; r < 4; ++r) { const int row = row0 + r * NGW; f32x4* xr = (f32x4*)(x + (size_t)row * D) + lane;
            float ss = 0.f;
#pragma unroll
            for (int j = 0; j < 4; ++j) ss += (v[r][j].x * v[r][j].x + v[r][j].y * v[r][j].y) + (v[r][j].z * v[r][j].z + v[r][j].w * v[r][j].w);
            const float rstd = 1.f / sqrtf(wave_sum(ss) * (1.f / D) + EPS);
#pragma unroll
            for (int j = 0; j < 4; ++j) xr[64 * j] = v[r][j] * rstd * gg[j]; }
    }
}
template <int MODE, int COLS>
__device__ __forceinline__ void chain_gemv(LAS unsigned char* lds, const float* W, int K, int N, const float* in, float* out, const float* base, size_t bstride, const float* gate, int bid, int G, int tid, int lane, int wave) {
    constexpr int KS = 64 / COLS;
    const int nitem = N / COLS;
    if (bid >= nitem) return;
    const int Kw = K >> 3, k0 = wave * Kw, col = lane & (COLS - 1), ksub = lane / COLS;
    LAS float* lin = (LAS float*)lds + wave * (8 * Kw);
    LAS float* red = (LAS float*)(lds + 131072 + 256);
    for (int c0 = 0; c0 < 8 * (Kw >> 6); c0 += 16) {
        float tv[16];
#pragma unroll
        for (int c = 0; c < 16; ++c) { const int cc = c0 + c, b = cc / (Kw >> 6), kk = lane + 64 * (cc % (Kw >> 6)); tv[c] = in[(size_t)b * K + k0 + kk]; }
        __builtin_amdgcn_sched_barrier(0);
#pragma unroll
        for (int c = 0; c < 16; ++c) { const int cc = c0 + c, b = cc / (Kw >> 6), kk = lane + 64 * (cc % (Kw >> 6)); lin[b * Kw + kk] = tv[c]; }
    }
    LDS_WAIT(); asm volatile("" ::: "memory");
    const bool swz = (G == 256 && nitem == 256);
    for (int it = bid; it < nitem; it += G) {
        const int item = swz ? (it & 7) * 32 + (it >> 3) : it;
        const float* Wp = W + (size_t)(k0 + ksub) * N + item * COLS + col;
        float acc[8];
#pragma unroll
        for (int b = 0; b < 8; ++b) acc[b] = 0.f;
        const int nj = Kw / KS;
        constexpr int JB = (COLS == 16) ? 32 : 8;
        for (int j0 = 0; j0 < nj; j0 += JB) {
            float wv[JB];
#pragma unroll
            for (int j = 0; j < JB; ++j) wv[j] = Wp[(size_t)(KS * (j0 + j)) * N];
#pragma unroll
            for (int j = 0; j < JB; ++j)
#pragma unroll
                for (int b = 0; b < 8; ++b) acc[b] += lin[b * Kw + KS * (j0 + j) + ksub] * wv[j];
        }
#pragma unroll
        for (int b = 0; b < 8; ++b) {
#pragma unroll
            for (int o = COLS; o < 64; o <<= 1) acc[b] += __shfl_xor(acc[b], o); }
        if (ksub == 0) {
#pragma unroll
            for (int b = 0; b < 8; ++b) red[(wave * 8 + b) * COLS + col] = acc[b]; }
        __syncthreads();
        if (tid < 8 * COLS) { const int b = tid / COLS, c = tid & (COLS - 1), n = item * COLS + c; float s = 0.f;
#pragma unroll
            for (int w = 0; w < 8; ++w) s += red[(w * 8 + b) * COLS + c];
            if (MODE == 0) out[(size_t)b * N + n] = s;
            else if (MODE == 2) { const float r = fmaxf(s, 0.f); out[(size_t)b * N + n] = r * r; }
            else out[(size_t)b * N + n] = base[(size_t)b * bstride + n] + gate[b * NMOD + n] * s; }
        __syncthreads();
    }
}
__device__ __forceinline__ void chain_mixer(const float* proj0, const float* cw, const float* retg, float* y0, int wave, int lane) {
    const float* p = proj0 + wave * NIN; float* y = y0 + wave * D;
    float pv[56], cwv[8], rg[8];
#pragma unroll
    for (int i = 0; i < 56; ++i) pv[i] = p[lane + 64 * i];
#pragma unroll
    for (int i = 0; i < 8; ++i) { cwv[i] = cw[1024 + lane + 64 * i]; rg[i] = retg[lane + 64 * i]; }
    __builtin_amdgcn_sched_barrier(0);
#pragma unroll
    for (int i = 0; i < 8; ++i) y[lane + 64 * i] = pv[i] * (cwv[i] * (pv[8 + i] * pv[16 + i]));
#pragma unroll
    for (int h = 0; h < NHEAD; ++h) {
        const float q0 = pv[24 + 2 * h], q1 = pv[25 + 2 * h], k0 = pv[32 + 2 * h], k1 = pv[33 + 2 * h], v0 = pv[40 + 2 * h], v1 = pv[41 + 2 * h], g0 = pv[48 + 2 * h], g1 = pv[49 + 2 * h];
        const float score = wave_sum(q0 * k0 + q1 * k1) * 0.08838834764831845f;
        const float o0 = score * v0, o1 = score * v1;
        const float mu = wave_sum(o0 + o1) * (1.f / 128.f);
        const float d0 = o0 - mu, d1 = o1 - mu;
        const float rstd = 1.f / sqrtf(wave_sum(d0 * d0 + d1 * d1) * (1.f / 128.f) + EPS);
        y[512 + h * 128 + lane] = (g0 / (1.f + __expf(-g0))) * (d0 * rstd * rg[2 * h]);
        y[512 + h * 128 + lane + 64] = (g1 / (1.f + __expf(-g1))) * (d1 * rstd * rg[2 * h + 1]);
    }
}

#define MFMA16(a, b, c) __builtin_amdgcn_mfma_f32_16x16x32_bf16(a, b, c, 0, 0, 0)
__device__ __forceinline__ void ret_scan_phase(const bf16* KVT, bf16* ST, const float* cdtab, int bid, int G, int wave, int lane) {
    const int fr = lane & 15, fq = lane >> 4;
    for (int unit = bid; unit < 256; unit += G) {
        const int bh = (unit & 7) * 4 + (unit >> 6), es = (unit >> 3) & 7, h = bh & 3, b = bh >> 2;
        const float cd = cdtab[h];
        const bf16* kp0 = KVT + (size_t)(h * 128 + 16 * wave + fr) * KVT_LD + (size_t)b * T + 8 * fq;
        const bf16* kp1 = kp0 + (size_t)64 * KVT_LD;
        const bf16* vp = KVT + (size_t)(512 + h * 128 + 16 * es + fr) * KVT_LD + (size_t)b * T + 8 * fq;
        bf16* sp = ST + (size_t)((b * 4 + h) * NCH) * 16384 + (16 * es + fr) * 128 + 16 * wave + 4 * fq;
        f32x4 acc0 = {0.f, 0.f, 0.f, 0.f}, acc1 = {0.f, 0.f, 0.f, 0.f};
        bf16x8 x0[2][4], x1[2][4], ys[2][4];
#pragma unroll
        for (int s = 0; s < 2; ++s)
#pragma unroll
            for (int kk = 0; kk < 4; ++kk) { x0[s][kk] = *(const bf16x8*)(kp0 + s * 128 + 32 * kk); x1[s][kk] = *(const bf16x8*)(kp1 + s * 128 + 32 * kk); ys[s][kk] = *(const bf16x8*)(vp + s * 128 + 32 * kk); }
#pragma unroll
        for (int n = 0; n < NCH; n += 2) {
#pragma unroll
            for (int s = 0; s < 2; ++s) {
                { v2u o; o.x = pk2(acc0[0], acc0[1]); o.y = pk2(acc0[2], acc0[3]); *(v2u*)(sp + (size_t)(n + s) * 16384) = o;
                  o.x = pk2(acc1[0], acc1[1]); o.y = pk2(acc1[2], acc1[3]); *(v2u*)(sp + (size_t)(n + s) * 16384 + 64) = o; }
#pragma unroll
                for (int kk = 0; kk < 4; ++kk) { acc0 = MFMA16(x0[s][kk], ys[s][kk], acc0); acc1 = MFMA16(x1[s][kk], ys[s][kk], acc1); }
                acc0 = acc0 * cd; acc1 = acc1 * cd;
                if (n + 2 < NCH) {
#pragma unroll
                    for (int kk = 0; kk < 4; ++kk) { x0[s][kk] = *(const bf16x8*)(kp0 + (n + s + 2) * 128 + 32 * kk); x1[s][kk] = *(const bf16x8*)(kp1 + (n + s + 2) * 128 + 32 * kk); ys[s][kk] = *(const bf16x8*)(vp + (n + s + 2) * 128 + 32 * kk); }
                }
            }
        }
    }
}
__device__ __forceinline__ void conv_phase(const bf16* P1, const float* cw, bf16* Y, int gw, int NGW, int lane) {
    float w0[8], w1[8], w2[8];
#pragma unroll
    for (int k = 0; k < 8; ++k) { w0[k] = cw[8 * lane + k]; w1[k] = cw[512 + 8 * lane + k]; w2[k] = cw[1024 + 8 * lane + k]; }
    for (int run = gw; run < M / 16; run += NGW) {
        const int tok0 = run * 16, t0 = tok0 & 4095;
        float z1[8], z2[8];
#pragma unroll
        for (int k = 0; k < 8; ++k) { z1[k] = 0.f; z2[k] = 0.f; }
        if (t0 != 0) {
            const bf16* r2 = P1 + (size_t)(tok0 - 2) * N1 + 8 * lane; const bf16* r1 = r2 + N1;
            const v4u c2 = *(const v4u*)(r2 + 512), c1 = *(const v4u*)(r1 + 512);
#pragma unroll
            for (int k = 0; k < 4; ++k) { z2[2 * k] = bflo(c2[k]); z2[2 * k + 1] = bfhi(c2[k]); z1[2 * k] = bflo(c1[k]); z1[2 * k + 1] = bfhi(c1[k]); }
        }
        for (int i0 = 0; i0 < 16; i0 += 8) {
            v4u bbv[8], ccv[8];
#pragma unroll
            for (int i = 0; i < 8; ++i) { const bf16* r = P1 + (size_t)(tok0 + i0 + i) * N1 + 8 * lane; bbv[i] = *(const v4u*)r; ccv[i] = *(const v4u*)(r + 512); }
            __builtin_amdgcn_sched_barrier(0);
#pragma unroll
            for (int i = 0; i < 8; ++i) {
                const v4u bb = bbv[i], cc = ccv[i];
                float z0[8], y[8];
#pragma unroll
                for (int k = 0; k < 4; ++k) { z0[2 * k] = bflo(cc[k]); z0[2 * k + 1] = bfhi(cc[k]); }
#pragma unroll
                for (int k = 0; k < 4; ++k) {
                    y[2 * k] = bflo(bb[k]) * (w0[2 * k] * z2[2 * k] + w1[2 * k] * z1[2 * k] + w2[2 * k] * z0[2 * k]);
                    y[2 * k + 1] = bfhi(bb[k]) * (w0[2 * k + 1] * z2[2 * k + 1] + w1[2 * k + 1] * z1[2 * k + 1] + w2[2 * k + 1] * z0[2 * k + 1]);
                }
                v4u o; o.x = pk2(y[0], y[1]); o.y = pk2(y[2], y[3]); o.z = pk2(y[4], y[5]); o.w = pk2(y[6], y[7]);
                *(v4u*)(Y + (size_t)(tok0 + i0 + i) * D + 8 * lane) = o;
#pragma unroll
                for (int k = 0; k < 8; ++k) { z2[k] = z1[k]; z1[k] = z0[k]; }
            }
            __builtin_amdgcn_sched_barrier(0);
        }
    }
}
__device__ __forceinline__ void ret_out_phase(const bf16* P1, const bf16* KVT, const bf16* ST, const float* retg, bf16* Y, LAS unsigned char* lds, int bid, int G, int tid, int wave, int lane) {
    constexpr int NU = BATCH * NHEAD * NCH, PITCH = 272, TILE = 128 * PITCH;
    const int fr = lane & 15, fq = lane >> 4;
    LAS unsigned char* lS = lds; LAS unsigned char* lK = lds + TILE; LAS unsigned char* lV = lds + 2 * TILE;
    v4u pS[4], pK[4], pV[4]; bf16x8 qn[4]; v2u gn[8];
#define R2_ISSUE(unit_, w_) do { const int n_ = (unit_) & 31, h_ = ((unit_) >> 5) & 3, b_ = (unit_) >> 7; const size_t tok0_ = (size_t)b_ * T + 128 * n_; \
        _Pragma("unroll") for (int i = 0; i < 4; ++i) { const int idx = tid + NTHR * i, r = idx >> 4, c = idx & 15; \
            pS[i] = *(const v4u*)(ST + (size_t)(unit_) * 16384 + r * 128 + c * 8); \
            pK[i] = *(const v4u*)(P1 + (tok0_ + r) * N1 + 2048 + h_ * 128 + c * 8); \
            pV[i] = *(const v4u*)(KVT + (size_t)(512 + h_ * 128 + r) * KVT_LD + tok0_ + c * 8); } \
        const bf16* qr_ = P1 + (tok0_ + 16 * (w_) + fr) * N1 + h_ * 128; \
        _Pragma("unroll") for (int kd = 0; kd < 4; ++kd) qn[kd] = *(const bf16x8*)(qr_ + 1536 + 8 * fq + 32 * kd); \
        _Pragma("unroll") for (int te = 0; te < 8; ++te) gn[te] = *(const v2u*)(qr_ + 2560 + 4 * fq + 16 * te); } while (0)
#define R2_WRITE() do { _Pragma("unroll") for (int i = 0; i < 4; ++i) { const int idx = tid + NTHR * i, r = idx >> 4, c = idx & 15; \
            *(LAS v4u*)(lS + r * PITCH + c * 16) = pS[i]; *(LAS v4u*)(lK + r * PITCH + c * 16) = pK[i]; *(LAS v4u*)(lV + r * PITCH + c * 16) = pV[i]; } } while (0)
    int uc = 0, unit = bid;
    if (unit < NU) { R2_ISSUE(unit, wave); R2_WRITE(); }
    __syncthreads();
    for (; unit < NU; unit += G, ++uc) {
        const int w = (uc & 1) ? 7 - wave : wave;
        const int n = unit & 31, h = (unit >> 5) & 3, b = unit >> 7;
        const size_t tok0 = (size_t)b * T + 128 * n;
        bf16x8 qf[4]; v2u gq[8];
#pragma unroll
        for (int kd = 0; kd < 4; ++kd) qf[kd] = qn[kd];
#pragma unroll
        for (int te = 0; te < 8; ++te) gq[te] = gn[te];
        const int nxt = unit + G; const bool has = nxt < NU;
        if (has) { const int wn = ((uc + 1) & 1) ? 7 - wave : wave; R2_ISSUE(nxt, wn); }
        __builtin_amdgcn_sched_barrier(0);
        f32x4 o[8];
#pragma unroll
        for (int te = 0; te < 8; ++te) o[te] = (f32x4){0.f, 0.f, 0.f, 0.f};
#pragma unroll
        for (int te = 0; te < 8; ++te)
#pragma unroll
            for (int kd = 0; kd < 4; ++kd) o[te] = MFMA16(*(const LAS bf16x8*)(lS + (16 * te + fr) * PITCH + kd * 64 + fq * 16), qf[kd], o[te]);
        const int nb = (w >> 1) + 1;
        for (int kk = 0; kk < nb; ++kk) {
            f32x4 sc[2];
#pragma unroll
            for (int t01 = 0; t01 < 2; ++t01) { sc[t01] = (f32x4){0.f, 0.f, 0.f, 0.f};
                const LAS unsigned char* kr = lK + (32 * kk + 8 * (fr >> 2) + (fr & 3) + 4 * t01) * PITCH + fq * 16;
#pragma unroll
                for (int kd = 0; kd < 4; ++kd) sc[t01] = MFMA16(*(const LAS bf16x8*)(kr + kd * 64), qf[kd], sc[t01]); }
            if (kk == nb - 1) { const int i = 16 * w + fr;
#pragma unroll
                for (int t01 = 0; t01 < 2; ++t01)
#pragma unroll
                    for (int r = 0; r < 4; ++r) { const int j = 32 * kk + 8 * fq + 4 * t01 + r; if (j > i) sc[t01][r] = 0.f; } }
            v4u pw; pw.x = pk2(sc[0][0], sc[0][1]); pw.y = pk2(sc[0][2], sc[0][3]); pw.z = pk2(sc[1][0], sc[1][1]); pw.w = pk2(sc[1][2], sc[1][3]);
            const bf16x8 pf = __builtin_bit_cast(bf16x8, pw);
#pragma unroll
            for (int te = 0; te < 8; ++te) o[te] = MFMA16(*(const LAS bf16x8*)(lV + (16 * te + fr) * PITCH + kk * 64 + fq * 16), pf, o[te]);
        }
        float s = 0.f;
#pragma unroll
        for (int te = 0; te < 8; ++te) s += (o[te][0] + o[te][1]) + (o[te][2] + o[te][3]);
        s += __shfl_xor(s, 16); s += __shfl_xor(s, 32);
        const float mean = s * (1.f / 128.f); float q = 0.f;
#pragma unroll
        for (int te = 0; te < 8; ++te) { const f32x4 dlt = o[te] - mean; q += (dlt[0] * dlt[0] + dlt[1] * dlt[1]) + (dlt[2] * dlt[2] + dlt[3] * dlt[3]); }
        q += __shfl_xor(q, 16); q += __shfl_xor(q, 32);
        const float rstd = 1.f / sqrtf(q * (1.f / 128.f) + EPS);
        bf16* yrow = Y + (tok0 + 16 * w + fr) * D + 512 + h * 128 + 4 * fq;
        const float* gg = retg + h * 128 + 4 * fq;
#pragma unroll
        for (int te = 0; te < 8; ++te) {
            const v2u gw2 = gq[te]; const f32x4 g4 = *(const f32x4*)(gg + 16 * te);
            float gv[4] = {bflo(gw2.x), bfhi(gw2.x), bflo(gw2.y), bfhi(gw2.y)}; float y[4];
#pragma unroll
            for (int r = 0; r < 4; ++r) { const float sl = gv[r] / (1.f + __expf(-gv[r])); y[r] = (o[te][r] - mean) * rstd * g4[r] * sl; }
            v2u ov; ov.x = pk2(y[0], y[1]); ov.y = pk2(y[2], y[3]);
            *(v2u*)(yrow + 16 * te) = ov;
        }
        __syncthreads();
        if (has) R2_WRITE();
        __syncthreads();
    }
#undef R2_ISSUE
#undef R2_WRITE
}

#define XB_TMO      128
#define XB_XCNT(j)  (256  + 64 * (j))
#define XB_XSUB(j)  (1280 + 64 * (j))
#define XB_XGEN(j)  (2304 + 64 * (j))
#define XB_TOP      3328
#define XB_TOPGEN   3392
#define XCD_BAR_WORDS 3456
#define XB_SPIN_CAP (1u << 18)

__device__ __forceinline__ unsigned xb_ld(unsigned* p)              { return __hip_atomic_load(p, __ATOMIC_RELAXED, __HIP_MEMORY_SCOPE_AGENT); }
__device__ __forceinline__ unsigned xb_add(unsigned* p, unsigned v) { return __hip_atomic_fetch_add(p, v, __ATOMIC_RELAXED, __HIP_MEMORY_SCOPE_AGENT); }
__device__ __forceinline__ unsigned xb_xcc_id() { return (unsigned)__builtin_amdgcn_s_getreg((3 << 11) | 20) & 0xFu; }
#define XB_SPIN(cond, bar) do { unsigned _sp = 0; while (cond) { __builtin_amdgcn_s_sleep(1); \
    if ((++_sp & 255u) == 0u) { if (xb_ld(&(bar)[XB_TMO])) break; if (_sp > XB_SPIN_CAP) { atomicAdd(&(bar)[XB_TMO], 1u); break; } } } } while (0)

struct XcdBarrier {
    unsigned* bar; unsigned x;
    volatile LAS unsigned* st;
};

__device__ __forceinline__ XcdBarrier xcd_barrier_post(unsigned* bar, volatile LAS unsigned* st) {
    XcdBarrier b; b.bar = bar; b.x = xb_xcc_id(); b.st = st;
    if (threadIdx.x == 0) (void)xb_add(&bar[XB_XCNT(b.x)], 1u);
    return b;
}
__device__ __forceinline__ void xcd_barrier_complete(unsigned* bar, unsigned x, unsigned& nloc, unsigned& nx) {
    const unsigned G = gridDim.x * gridDim.y * gridDim.z;
    unsigned sum, cnt, mine, sp = 0u;
    for (;;) {
        sum = 0u; cnt = 0u; mine = 0u;
#pragma unroll
        for (unsigned j = 0; j < 16; ++j) { const unsigned c = xb_ld(&bar[XB_XCNT(j)]); sum += c; cnt += (c > 0u) ? 1u : 0u; mine = (j == x) ? c : mine; }
        if (sum == G) break;
        __builtin_amdgcn_s_sleep(1);
        if ((++sp & 255u) == 0u) { if (xb_ld(&bar[XB_TMO])) break; if (sp > XB_SPIN_CAP) { atomicAdd(&bar[XB_TMO], 1u); break; } }
    }
    nloc = mine > 0u ? mine : 1u; nx = cnt > 0u ? cnt : 1u;
}

__device__ __forceinline__ void xcd_barrier(const XcdBarrier& b) {
    asm volatile("s_waitcnt vmcnt(0)" ::: "memory");
    __syncthreads();
    if (threadIdx.x == 0) {
        unsigned* bar = b.bar;
        __builtin_amdgcn_s_waitcnt(0);
        unsigned nloc = b.st[0], nx = b.st[1];
        if (nloc == 0u) { xcd_barrier_complete(bar, b.x, nloc, nx); b.st[0] = nloc; b.st[1] = nx; }
        const unsigned old = xb_add(&bar[XB_XSUB(b.x)], 1u);
        const unsigned gen = old / nloc;
        if (old + 1u == (gen + 1u) * nloc) {
            __builtin_amdgcn_fence(__ATOMIC_RELEASE, "agent");
            asm volatile("s_waitcnt vmcnt(0)" ::: "memory");
            const unsigned og = xb_add(&bar[XB_TOP], 1u);
            const unsigned tg = og / nx;
            if (og + 1u == (tg + 1u) * nx) xb_add(&bar[XB_TOPGEN], 1u);
            else XB_SPIN(xb_ld(&bar[XB_TOPGEN]) == tg, bar);
            __builtin_amdgcn_fence(__ATOMIC_ACQUIRE, "agent");
            xb_add(&bar[XB_XGEN(b.x)], 1u);
            asm volatile("s_waitcnt vmcnt(0)" ::: "memory");
        } else {
            XB_SPIN(xb_ld(&bar[XB_XGEN(b.x)]) == gen, bar);
            __builtin_amdgcn_fence(__ATOMIC_ACQUIRE, "agent");
            asm volatile("s_waitcnt vmcnt(0)" ::: "memory");
        }
    }
    __syncthreads();
}

__device__ __forceinline__ unsigned long long tab_get(int k, LAS unsigned char* lds) {
    const LAS unsigned* t = (const LAS unsigned*)(lds + 131072) + 2 * k;
    const unsigned lo = __builtin_amdgcn_readfirstlane(t[0]), hi = __builtin_amdgcn_readfirstlane(t[1]);
    return ((unsigned long long)hi << 32) | lo;
}
__global__ void __launch_bounds__(NTHR, 2) fwd_kernel(Args a) {
    extern __shared__ __attribute__((aligned(16))) unsigned char lds_raw[];
    cg::grid_group grid = cg::this_grid();
    LAS unsigned char* lds = (LAS unsigned char*)lds_raw;
    const int lo = a.ph_lo, hi = a.ph_hi; int ph = 0;
    if (threadIdx.x == 0) {
        LAS unsigned long long* t = (LAS unsigned long long*)(lds + 131072);
#pragma unroll
        for (int i = 0; i < 13; ++i) t[i] = (unsigned long long)a.in[i];
        t[13] = (unsigned long long)a.out; t[14] = (unsigned long long)a.ws;
        ((LAS unsigned*)(lds + 131072 + 128))[0] = 0u; ((LAS unsigned*)(lds + 131072 + 128))[1] = 0u;
    }
    if (blockIdx.x == 0) { unsigned* bw = (unsigned*)(a.ws + WS_BAR); for (int i = threadIdx.x; i < XCD_BAR_WORDS; i += NTHR) bw[i] = 0u; }
    __syncthreads();
#define GASP __attribute__((address_space(1)))
#define IN(k) ((const float*)(const GASP float*)tab_get((k), lds))
#define XO() ((float*)(GASP float*)tab_get(13, lds))
#define WS() ((unsigned char*)(GASP unsigned char*)tab_get(14, lds))
#define RUN(k) (lo <= (k) && (k) < hi)
#define BG() int bid = blockIdx.x, G = gridDim.x; asm volatile("" : "+s"(bid), "+s"(G))
#define LT() BG(); const int NGW = G * NWAVES; int tid = threadIdx.x; asm volatile("" : "+v"(tid)); const int lane = tid & 63, wave = __builtin_amdgcn_readfirstlane(tid >> 6), gw = bid * NWAVES + wave; (void)lane; (void)gw; (void)NGW
#define SEAM() do { ++ph; if (lo < ph && ph < hi) { \
    if (ph == 1 || MK_CG_ONLY) { asm volatile("s_waitcnt vmcnt(0) lgkmcnt(0)" ::: "memory"); __syncthreads();   \
        if (threadIdx.x == 0) { __builtin_amdgcn_fence(__ATOMIC_RELEASE, "agent"); asm volatile("s_waitcnt vmcnt(0)" ::: "memory"); }   \
        for (int xs_ = 0; xs_ < 1 + XSYNC; ++xs_) grid.sync(); \
        if (threadIdx.x == 0) { __builtin_amdgcn_fence(__ATOMIC_ACQUIRE, "agent"); asm volatile("s_waitcnt vmcnt(0)" ::: "memory"); } __syncthreads(); \
        if (!MK_CG_ONLY) (void)xcd_barrier_post((unsigned*)(WS() + WS_BAR), (volatile LAS unsigned*)(lds + 131072 + 128)); } \
    else { XcdBarrier xb_; xb_.bar = (unsigned*)(WS() + WS_BAR); xb_.x = xb_xcc_id(); xb_.st = (volatile LAS unsigned*)(lds + 131072 + 128); \
        for (int xs_ = 0; xs_ < 1 + XSYNC; ++xs_) xcd_barrier(xb_); } } } while (0)

#if defined(MK_NANFILL) && MK_NANFILL
    if (RUN(ph)) { LT(); unsigned char* ws = WS(); v4u* p = (v4u*)(ws + WS_COS); const size_t n16 = (WS_END - WS_COS) / 16; const v4u q = {0xffffffffu, 0xffffffffu, 0xffffffffu, 0xffffffffu};
        for (size_t i = (size_t)bid * NTHR + tid; i < n16; i += (size_t)G * NTHR) p[i] = q;
        { v4u* z = (v4u*)(ws + WS_MOD); const v4u zz = {0u, 0u, 0u, 0u}; for (size_t i = (size_t)bid * NTHR + tid; i < CTL_ZERO_BYTES / 16; i += (size_t)G * NTHR) z[i] = zz; }
        v4u* o = (v4u*)XO(); for (size_t i = (size_t)bid * NTHR + tid; i < (size_t)M * D / 4; i += (size_t)G * NTHR) o[i] = q; }
    SEAM();
#endif
    if (RUN(ph)) for (int rep_ = 0; rep_ < REP_PRO; ++rep_) { LT(); prologue(a, lds, tid, lane, wave, bid, G); }
    SEAM();
    for (int l = 0; l < DEPTH; ++l) {
        if (RUN(ph)) for (int rep_ = 0; rep_ < REP_NORM; ++rep_) { LT(); unsigned char* ws = WS(); const float* modl = (const float*)(ws + WS_MOD) + (size_t)l * 8 * NMOD;
            norm_mod_phase(l == 0 ? IN(0) : (const float*)XO(), l == 0 ? IN(0) : (const float*)(ws + CH_X0), l == 0 ? (size_t)T * D : (size_t)D, (float*)(ws + CH_H0), IN(2) + l * D, modl, modl + D, (bf16*)(ws + WS_XN), gw, NGW, lane); }
        SEAM();
        if (RUN(ph)) for (int rep_ = 0; rep_ < REP_GEMM_IN; ++rep_) {
            { BG(); unsigned char* ws = WS(); unsigned char* wl = ws + WS_W + (size_t)l * W_LAYER;
              static_assert(W_T2 == W_T1 + (size_t)N1 * D * 2, "the v weight rows continue Wt1");
              pg8::Gemm g{(const bf16*)(ws + WS_XN), (const bf16*)(wl + W_T1), M, NIN, D}; pg8::StaticOrder S; S.init(M, NIN, G, bid);
              pg8::EpiInProj E{(bf16*)(ws + WS_P1), (const float*)(ws + WS_COS), (const float*)(ws + WS_SIN), (const float*)(ws + WS_DQ), (const float*)(ws + WS_DK), (bf16*)(ws + WS_KVT), KVT_LD};
              pg8::gemm_phase<pg8::EpiInProj, pg8::StaticOrder, true, true>(lds, g, S, E); }
            { LT(); unsigned char* ws = WS(); chain_gemv<0, 16>(lds, IN(3) + (size_t)l * D * NIN, D, NIN, (const float*)(ws + CH_H0), (float*)(ws + CH_P0), nullptr, 0, nullptr, bid, G, tid, lane, wave); }
        }
        SEAM();
        if (RUN(ph)) for (int rep_ = 0; rep_ < REP_RET1; ++rep_) { LT(); unsigned char* ws = WS();
            if (wave < 4) ret_scan_phase((const bf16*)(ws + WS_KVT), (bf16*)(ws + WS_ST), (const float*)(ws + WS_DK) + 512, bid, G, wave, lane);
            else conv_phase((const bf16*)(ws + WS_P1), IN(4) + l * 3 * 512, (bf16*)(ws + WS_XN), bid * 4 + (wave - 4), G * 4, lane);
            if (bid == G - 1) chain_mixer((const float*)(ws + CH_P0), IN(4) + l * 3 * 512, IN(5) + l * 512, (float*)(ws + CH_Y0), wave, lane); }
        SEAM();
        if (RUN(ph)) for (int rep_ = 0; rep_ < REP_RET2; ++rep_) { LT(); unsigned char* ws = WS();
            ret_out_phase((const bf16*)(ws + WS_P1), (const bf16*)(ws + WS_KVT), (const bf16*)(ws + WS_ST), IN(5) + l * 512, (bf16*)(ws + WS_XN), lds, bid, G, tid, wave, lane); }
        SEAM();
        if (RUN(ph)) { BG(); unsigned char* ws = WS(); unsigned char* wl = ws + WS_W + (size_t)l * W_LAYER;
            const float* modl = (const float*)(ws + WS_MOD) + (size_t)l * 8 * NMOD;
            pg8::Gemm g{(const bf16*)(ws + WS_XN), (const bf16*)(wl + W_O), M, D, D}; pg8::StaticOrder S; S.init(M, D, G, bid);
            pg8::EpiRes E{l == 0 ? IN(0) : (const float*)XO(), XO(), modl + 2 * D};
            pg8::gemm_phase<pg8::EpiRes, pg8::StaticOrder, true, true>(lds, g, S, E);
            { LT(); unsigned char* ws = WS(); const float* modl = (const float*)(ws + WS_MOD) + (size_t)l * 8 * NMOD;
              chain_gemv<1, 4>(lds, IN(6) + (size_t)l * D * D, D, D, (const float*)(ws + CH_Y0), (float*)(ws + CH_X0), l == 0 ? IN(0) : (const float*)(ws + CH_X0), l == 0 ? (size_t)T * D : (size_t)D, modl + 2 * D, bid, G, tid, lane, wave); } }
        SEAM();
        if (RUN(ph)) for (int rep_ = 0; rep_ < REP_NORM; ++rep_) { LT(); unsigned char* ws = WS(); const float* modl = (const float*)(ws + WS_MOD) + (size_t)l * 8 * NMOD;
            norm_mod_phase(XO(), (const float*)(ws + CH_X0), (size_t)D, (float*)(ws + CH_H0), IN(7) + l * D, modl + 3 * D, modl + 4 * D, (bf16*)(ws + WS_XN), gw, NGW, lane); }
        SEAM();
        if (RUN(ph)) for (int rep_ = 0; rep_ < REP_GEMM_UP; ++rep_) { BG(); unsigned char* ws = WS(); unsigned char* wl = ws + WS_W + (size_t)l * W_LAYER;
            pg8::Gemm g{(const bf16*)(ws + WS_XN), (const bf16*)(wl + W_U), M, FF, D}; pg8::StaticOrder S; S.init(M, FF, G, bid);
            pg8::EpiRelu2 E{(bf16*)(ws + WS_H), FF};
            pg8::gemm_phase<pg8::EpiRelu2, pg8::StaticOrder, true, true>(lds, g, S, E);
            { LT(); unsigned char* ws = WS(); chain_gemv<2, 16>(lds, IN(8) + (size_t)l * D * FF, D, FF, (const float*)(ws + CH_H0), (float*)(ws + CH_U0), nullptr, 0, nullptr, bid, G, tid, lane, wave); } }
        SEAM();
        if (RUN(ph)) { BG(); unsigned char* ws = WS(); unsigned char* wl = ws + WS_W + (size_t)l * W_LAYER;
            const float* modl = (const float*)(ws + WS_MOD) + (size_t)l * 8 * NMOD;
            pg8::Gemm g{(const bf16*)(ws + WS_H), (const bf16*)(wl + W_D), M, D, FF}; pg8::StaticOrder S; S.init(M, D, G, bid);
            pg8::EpiRes E{XO(), XO(), modl + 5 * D};
            pg8::gemm_phase<pg8::EpiRes, pg8::StaticOrder, true, true>(lds, g, S, E);
            { LT(); unsigned char* ws = WS(); const float* modl = (const float*)(ws + WS_MOD) + (size_t)l * 8 * NMOD;
              chain_gemv<1, 4>(lds, IN(9) + (size_t)l * FF * D, FF, D, (const float*)(ws + CH_U0), (float*)(ws + CH_X0), (const float*)(ws + CH_X0), (size_t)D, modl + 5 * D, bid, G, tid, lane, wave); } }
        SEAM();
    }
    if (RUN(ph)) { LT(); final_norm_phase(XO(), (const float*)(WS() + CH_X0), IN(12), gw, NGW, lane); }
#undef RUN
#undef SEAM
}

extern "C" void kernel_launch(void* const* d_in, const int* in_sizes, int n_in, void* d_out, int out_size, void* d_ws, size_t ws_size, hipStream_t stream) {
    static int grid = 0;
    if (grid == 0) {
        if (n_in != 13 || in_sizes[0] != M * D || out_size != M * D || ws_size < WS_END) { fprintf(stderr, "kernel_launch: unexpected shapes (n_in %d, in0 %d, out %d, ws %zu < %zu)\n", n_in, n_in > 0 ? in_sizes[0] : -1, out_size, ws_size, (size_t)WS_END); grid = -1; return; }
        int dev = 0, cus = 0, per_cu = 0;
        hipGetDevice(&dev); hipDeviceGetAttribute(&cus, hipDeviceAttributeMultiprocessorCount, dev);
        if (hipFuncSetAttribute((const void*)fwd_kernel, hipFuncAttributeMaxDynamicSharedMemorySize, LDS_BYTES) != hipSuccess) { fprintf(stderr, "kernel_launch: hipFuncSetAttribute failed\n"); grid = -1; return; }
        if (hipOccupancyMaxActiveBlocksPerMultiprocessor(&per_cu, (const void*)fwd_kernel, NTHR, LDS_BYTES) != hipSuccess || per_cu < 1) { fprintf(stderr, "kernel_launch: occupancy query gives %d\n", per_cu); per_cu = 1; }
        (void)hipGetLastError();
        grid = cus * per_cu;
    }
    if (grid < 0) return;
    Args a{};
    for (int i = 0; i < 13; ++i) a.in[i] = (const float*)d_in[i];
    a.out = (float*)d_out; a.ws = (unsigned char*)d_ws; a.ph_lo = 0; a.ph_hi = 1 << 20;
#if defined(MK_PER_PHASE) && MK_PER_PHASE
    for (int k = 0; k < 2 + MK_NANFILL + 8 * DEPTH; ++k) { a.ph_lo = k; a.ph_hi = k + 1; hipLaunchKernelGGL(fwd_kernel, dim3(grid), dim3(NTHR), LDS_BYTES, stream, a); }
#else
    void* args[] = {&a};
    hipError_t e = hipLaunchCooperativeKernel((const void*)fwd_kernel, dim3(grid), dim3(NTHR), args, LDS_BYTES, stream);
    if (e != hipSuccess) fprintf(stderr, "kernel_launch: cooperative launch failed: %s (grid %d)\n", hipGetErrorString(e), grid);
#endif
}
```
